# Optimizing an MI355X kernel written in HIP

```python
import math
import jax
import jax.numpy as jnp
from jax import lax
import numpy as np

D_MODEL = 2048
BATCH = 2
SEQ = 4096
DEPTH = 2

F32 = jnp.float32
EPS = 1e-6
ATTN_HEADS = 6
ATTN_QK_DIM = 64
ATTN_V_DIM = 2 * ATTN_QK_DIM
ATTN_WIDTH = ATTN_HEADS * ATTN_V_DIM
Q_BLOCK = 128
REL_BUCKETS = 32
REL_MAX_DIST = 128
S5_GROUPS = 40
S5_GROUP_CH = 16
S5_STATE = 64
S5_WIDTH = S5_GROUPS * S5_GROUP_CH
HGRN_HEADS = 5
HGRN_DIM = 128
HGRN_WIDTH = HGRN_HEADS * HGRN_DIM
HGRN_CHUNK = 16
MIX_WIDTH = ATTN_WIDTH + S5_WIDTH + HGRN_WIDTH
SPLIT_SIZES = (ATTN_WIDTH, ATTN_WIDTH, ATTN_WIDTH, S5_WIDTH, HGRN_WIDTH, HGRN_WIDTH, HGRN_WIDTH, HGRN_WIDTH)
IN_COLS = 3 * ATTN_WIDTH + S5_WIDTH + 4 * HGRN_WIDTH
N_GROUPS = 4
EXPERTS_PER_GROUP = 8
N_EXPERTS = N_GROUPS * EXPERTS_PER_GROUP
TOP_K_IN_GROUP = 2
D_EXPERT = 512

kernel_name = 'hymba_style_diffattn_s5_hgrn2_hmoe'


def rms_norm(x, g):
    xf = x.astype(F32)
    y = xf * lax.rsqrt(jnp.mean(xf * xf, axis=-1, keepdims=True) + EPS)
    return (y * g.astype(F32)).astype(x.dtype)


def t5_bucket(dist):
    n = jnp.maximum(dist, 0)
    max_exact = REL_BUCKETS // 2
    large = max_exact + (jnp.log(jnp.maximum(n, 1).astype(F32) / max_exact)
                         / math.log(REL_MAX_DIST / max_exact) * (REL_BUCKETS - max_exact)).astype(jnp.int32)
    large = jnp.minimum(large, REL_BUCKETS - 1)
    return jnp.where(n < max_exact, n, large)


def diff_attention(q, k, v, rel_bias, lam_vecs, subln_g, layer_idx):
    B_, S_ = q.shape[0], q.shape[1]
    n_blocks = S_ // Q_BLOCK
    scale = ATTN_QK_DIM ** -0.5
    lam_init = 0.8 - 0.6 * math.exp(-0.3 * layer_idx)
    lv = lam_vecs.astype(F32)
    lam = jnp.exp(jnp.sum(lv[0] * lv[1])) - jnp.exp(jnp.sum(lv[2] * lv[3])) + lam_init
    qf = q.astype(F32).reshape(B_, n_blocks, Q_BLOCK, ATTN_HEADS, 2, ATTN_QK_DIM).transpose(1, 0, 2, 3, 4, 5)
    kf = k.astype(F32).reshape(B_, S_, ATTN_HEADS, 2, ATTN_QK_DIM)
    vf = v.astype(F32).reshape(B_, S_, ATTN_HEADS, ATTN_V_DIM)
    table = rel_bias.astype(F32)
    k_pos = jnp.arange(S_)

    def one_block(args):
        i, q_blk = args
        q_pos = i * Q_BLOCK + jnp.arange(Q_BLOCK)
        dist = q_pos[:, None] - k_pos[None, :]
        bias = jnp.transpose(table[t5_bucket(dist)], (2, 0, 1))
        logits = jnp.einsum('bqhmd,bkhmd->bhmqk', q_blk, kf) * scale + bias[None, :, None]
        logits = jnp.where((dist >= 0)[None, None, None], logits, -jnp.inf)
        p = jax.nn.softmax(logits, axis=-1)
        w = p[:, :, 0] - lam * p[:, :, 1]
        return jnp.einsum('bhqk,bkhv->bqhv', w, vf)

    out = lax.map(one_block, (jnp.arange(n_blocks), qf))
    out = out.transpose(1, 0, 2, 3, 4).reshape(B_, S_, ATTN_HEADS, ATTN_V_DIM)
    out = rms_norm(out, subln_g) * (1.0 - lam_init)
    return out.reshape(B_, S_, ATTN_WIDTH).astype(q.dtype)


def s5_mixer(u, a_re, a_im, log_dt, b_re, b_im, c_re, c_im, d_skip, w_glu):
    B_, S_ = u.shape[0], u.shape[1]
    uf = u.astype(F32).reshape(B_, S_, S5_GROUPS, S5_GROUP_CH)
    lr = jnp.minimum(a_re.astype(F32), -1e-4)
    li = a_im.astype(F32)
    dt = jnp.exp(log_dt.astype(F32))[:, None]
    mag = jnp.exp(lr * dt)
    ab_re = mag * jnp.cos(li * dt)
    ab_im = mag * jnp.sin(li * dt)
    den = lr * lr + li * li
    nr = ab_re - 1.0
    ni = ab_im
    f_re = (nr * lr + ni * li) / den
    f_im = (ni * lr - nr * li) / den
    br = b_re.astype(F32)
    bi = b_im.astype(F32)
    bb_re = f_re[..., None] * br - f_im[..., None] * bi
    bb_im = f_re[..., None] * bi + f_im[..., None] * br
    bu_re = jnp.einsum('bsgc,gnc->bsgn', uf, bb_re)
    bu_im = jnp.einsum('bsgc,gnc->bsgn', uf, bb_im)
    ar = jnp.broadcast_to(ab_re, bu_re.shape)
    ai = jnp.broadcast_to(ab_im, bu_re.shape)

    def combine(e1, e2):
        a1r, a1i, b1r, b1i = e1
        a2r, a2i, b2r, b2i = e2
        return (a1r * a2r - a1i * a2i, a1r * a2i + a1i * a2r,
                a2r * b1r - a2i * b1i + b2r, a2r * b1i + a2i * b1r + b2i)

    _, _, xr, xi = lax.associative_scan(combine, (ar, ai, bu_re, bu_im), axis=1)
    y = jnp.einsum('bsgn,gcn->bsgc', xr, c_re.astype(F32)) - jnp.einsum('bsgn,gcn->bsgc', xi, c_im.astype(F32))
    y = y + d_skip.astype(F32).reshape(S5_GROUPS, S5_GROUP_CH) * uf
    z = jax.nn.gelu(y.reshape(B_, S_, S5_WIDTH))
    out = z * jax.nn.sigmoid(jnp.einsum('bsc,ce->bse', z, w_glu.astype(F32)))
    return out.astype(u.dtype)


def hgrn2_mixer(q, f_logit, i_val, g, lb, norm_g):
    B_, S_ = q.shape[0], q.shape[1]
    N_ = S_ // HGRN_CHUNK
    shp = (B_, N_, HGRN_CHUNK, HGRN_HEADS, HGRN_DIM)
    lbf = lb.astype(F32)
    fl = f_logit.astype(F32)
    logf = jnp.logaddexp(jnp.log(lbf), jnp.log1p(-lbf) + jax.nn.log_sigmoid(fl)).reshape(shp)
    kf = ((1.0 - lbf) * jax.nn.sigmoid(-fl)).reshape(shp)
    qf = (jax.nn.silu(q.astype(F32)) * HGRN_DIM ** -0.5).reshape(shp)
    vf = i_val.astype(F32).reshape(shp)
    G = jnp.cumsum(logf, axis=2)
    causal = jnp.tril(jnp.ones((HGRN_CHUNK, HGRN_CHUNK), dtype=bool))
    diff = G[:, :, :, None] - G[:, :, None, :]
    decay = jnp.where(causal[None, None, :, :, None, None], jnp.exp(jnp.minimum(diff, 0.0)), 0.0)
    scores = jnp.einsum('bnthd,bnshd,bntshd->bnhts', qf, kf, decay)
    o_intra = jnp.einsum('bnhts,bnshv->bnthv', scores, vf)
    g_last = G[:, :, -1]
    k_dec = kf * jnp.exp(g_last[:, :, None] - G)
    U = jnp.einsum('bnshd,bnshv->bnhdv', k_dec, vf)
    chunk_decay = jnp.exp(g_last)

    def step(S, inp):
        dec, inc = inp
        return dec[..., None] * S + inc, S

    S0 = jnp.zeros((B_, HGRN_HEADS, HGRN_DIM, HGRN_DIM), F32)
    _, S_prev = lax.scan(step, S0, (jnp.moveaxis(chunk_decay, 1, 0), jnp.moveaxis(U, 1, 0)))
    o_inter = jnp.einsum('bnthd,nbhdv->bnthv', qf * jnp.exp(G), S_prev)
    o = (o_intra + o_inter).reshape(B_, S_, HGRN_HEADS, HGRN_DIM)
    o = rms_norm(o, norm_g) * jax.nn.sigmoid(g.astype(F32)).reshape(B_, S_, HGRN_HEADS, HGRN_DIM)
    return o.reshape(B_, S_, HGRN_WIDTH).astype(q.dtype)


def hier_moe(x, w_group, w_router, w_gate, w_up, w_down):
    B_, S_, D_ = x.shape
    xt = x.reshape(-1, D_)
    T_ = xt.shape[0]
    xr = xt.astype(F32)
    gl = jnp.einsum('td,dg->tg', xr, w_group.astype(F32))
    gp = jax.nn.softmax(gl, axis=-1)
    g_idx = jnp.argmax(gl, axis=-1)
    p_g = jnp.take_along_axis(gp, g_idx[:, None], axis=1)[:, 0]
    el = jnp.einsum('td,de->te', xr, w_router.astype(F32)).reshape(T_, N_GROUPS, EXPERTS_PER_GROUP)
    el_sel = jnp.take_along_axis(el, g_idx[:, None, None], axis=1)[:, 0]
    top_vals, top_idx = lax.top_k(el_sel, TOP_K_IN_GROUP)
    gates = jax.nn.softmax(top_vals, axis=-1) * p_g[:, None]
    expert_id = (g_idx[:, None] * EXPERTS_PER_GROUP + top_idx).reshape(-1)
    gates_flat = gates.reshape(-1)
    order = jnp.argsort(expert_id)
    token_of = order // TOP_K_IN_GROUP
    xs = xt[token_of]
    sizes = jnp.bincount(expert_id, length=N_EXPERTS).astype(jnp.int32)
    h = jax.nn.silu(lax.ragged_dot(xs, w_gate, sizes)) * lax.ragged_dot(xs, w_up, sizes)
    y = lax.ragged_dot(h, w_down, sizes)
    y = y * gates_flat[order][:, None].astype(y.dtype)
    out = jnp.zeros_like(xt).at[token_of].add(y)
    return out.reshape(B_, S_, D_)


def setup_inputs(seed: int = 0) -> dict:
    key = jax.random.key(seed)
    ks = jax.random.split(key, 26)

    def nrm(k, shape, scale):
        return jax.random.normal(k, shape, F32) * scale

    return {
        'x': nrm(ks[0], (BATCH, SEQ, D_MODEL), 1.0),
        'w_in': nrm(ks[1], (DEPTH, D_MODEL, IN_COLS), D_MODEL ** -0.5),
        'w_out': nrm(ks[2], (DEPTH, MIX_WIDTH, D_MODEL), MIX_WIDTH ** -0.5),
        'mix_norm_g': 1.0 + nrm(ks[3], (DEPTH, D_MODEL), 0.02),
        'ffn_norm_g': 1.0 + nrm(ks[4], (DEPTH, D_MODEL), 0.02),
        'rel_bias': nrm(ks[5], (REL_BUCKETS, ATTN_HEADS), 0.5),
        'diff_lambda': nrm(ks[6], (DEPTH, 4, ATTN_QK_DIM), 0.1),
        'attn_subln_g': 1.0 + nrm(ks[7], (DEPTH, ATTN_V_DIM), 0.02),
        's5_a_re': -0.5 + nrm(ks[8], (DEPTH, S5_GROUPS, S5_STATE), 0.01),
        's5_a_im': math.pi * jnp.arange(S5_STATE, dtype=F32) + nrm(ks[9], (DEPTH, S5_GROUPS, S5_STATE), 0.01),
        's5_log_dt': jax.random.uniform(ks[10], (DEPTH, S5_GROUPS), F32, math.log(1e-3), math.log(1e-1)),
        's5_b_re': nrm(ks[11], (DEPTH, S5_GROUPS, S5_STATE, S5_GROUP_CH), (2 * S5_GROUP_CH) ** -0.5),
        's5_b_im': nrm(ks[12], (DEPTH, S5_GROUPS, S5_STATE, S5_GROUP_CH), (2 * S5_GROUP_CH) ** -0.5),
        's5_c_re': nrm(ks[13], (DEPTH, S5_GROUPS, S5_GROUP_CH, S5_STATE), S5_STATE ** -0.5),
        's5_c_im': nrm(ks[14], (DEPTH, S5_GROUPS, S5_GROUP_CH, S5_STATE), S5_STATE ** -0.5),
        's5_d': nrm(ks[15], (DEPTH, S5_WIDTH), 1.0),
        's5_w_glu': nrm(ks[16], (DEPTH, S5_WIDTH, S5_WIDTH), S5_WIDTH ** -0.5),
        'hgrn_lb_logits': nrm(ks[17], (DEPTH, HGRN_WIDTH), 0.5),
        'hgrn_norm_g': 1.0 + nrm(ks[18], (DEPTH, HGRN_DIM), 0.02),
        'moe_w_group': nrm(ks[19], (DEPTH, D_MODEL, N_GROUPS), D_MODEL ** -0.5),
        'moe_w_router': nrm(ks[20], (DEPTH, D_MODEL, N_EXPERTS), D_MODEL ** -0.5),
        'moe_w_gate': nrm(ks[21], (DEPTH, N_EXPERTS, D_MODEL, D_EXPERT), D_MODEL ** -0.5),
        'moe_w_up': nrm(ks[22], (DEPTH, N_EXPERTS, D_MODEL, D_EXPERT), D_MODEL ** -0.5),
        'moe_w_down': nrm(ks[23], (DEPTH, N_EXPERTS, D_EXPERT, D_MODEL), D_EXPERT ** -0.5),
        'final_norm_g': 1.0 + nrm(ks[24], (D_MODEL,), 0.02),
    }


def reference(x, w_in, w_out, mix_norm_g, ffn_norm_g, rel_bias, diff_lambda, attn_subln_g,
              s5_a_re, s5_a_im, s5_log_dt, s5_b_re, s5_b_im, s5_c_re, s5_c_im, s5_d, s5_w_glu,
              hgrn_lb_logits, hgrn_norm_g, moe_w_group, moe_w_router, moe_w_gate, moe_w_up,
              moe_w_down, final_norm_g):
    lb_cum = jnp.cumsum(jax.nn.softmax(hgrn_lb_logits.astype(F32), axis=0), axis=0)
    lb_all = lb_cum - lb_cum[0:1]
    split_at = np.cumsum(SPLIT_SIZES)[:-1]
    h = x
    for l in range(DEPTH):
        xn = rms_norm(h, mix_norm_g[l])
        proj = jnp.einsum('bsd,de->bse', xn, w_in[l])
        q_a, k_a, v_a, u_s5, q_h, f_h, i_h, g_h = jnp.split(proj, split_at, axis=-1)
        attn_out = diff_attention(q_a, k_a, v_a, rel_bias, diff_lambda[l], attn_subln_g[l], l)
        s5_out = s5_mixer(u_s5, s5_a_re[l], s5_a_im[l], s5_log_dt[l], s5_b_re[l], s5_b_im[l],
                          s5_c_re[l], s5_c_im[l], s5_d[l], s5_w_glu[l])
        hgrn_out = hgrn2_mixer(q_h, f_h, i_h, g_h, lb_all[l], hgrn_norm_g[l])
        mix = jnp.concatenate([attn_out, s5_out, hgrn_out], axis=-1)
        h = h + jnp.einsum('bse,ed->bsd', mix, w_out[l]).astype(h.dtype)
        hn = rms_norm(h, ffn_norm_g[l])
        h = h + hier_moe(hn, moe_w_group[l], moe_w_router[l], moe_w_gate[l], moe_w_up[l], moe_w_down[l]).astype(h.dtype)
    return rms_norm(h, final_norm_g)
```

```cpp
#include <hip/hip_runtime.h>
#include <cstdio>
#include <cstdint>
#include <cmath>

constexpr int DM = 2048, BATCH = 2, SEQ = 4096, DEPTH = 2, T = BATCH * SEQ;
constexpr int AH = 6, DK = 64, DV = 128, AW = 768;
constexpr int SG = 40, SC = 16, SN = 64, SW = 640;
constexpr int HH = 5, HD = 128, HW = 640;
constexpr int INC = 5504, INCP = 5632;
constexpr int NGRP = 4, EPG = 8, NE = 32, DE = 512;
constexpr float EPS = 1e-6f;
constexpr int S5L = 32, S5NC = T / S5L, S5LD = 640;

typedef unsigned short bf16;
#define GAS __attribute__((address_space(1)))
#define LAS __attribute__((address_space(3)))
typedef unsigned v4u __attribute__((ext_vector_type(4)));
typedef unsigned v2u __attribute__((ext_vector_type(2)));
typedef float f32x4 __attribute__((ext_vector_type(4)));
typedef short bf16x8 __attribute__((ext_vector_type(8)));

__device__ __forceinline__ int lane_id_() { unsigned m = ~0u; asm volatile("" : "+s"(m)); return (int)__builtin_amdgcn_mbcnt_hi(m, __builtin_amdgcn_mbcnt_lo(m, 0u)); }
__device__ __forceinline__ int tidx() {
    int w = __builtin_amdgcn_readfirstlane((int)(threadIdx.x >> 6)); asm volatile("" : "+s"(w));
    return (w << 6) | lane_id_(); }
__device__ __forceinline__ float shx(float v, int o) { return __builtin_bit_cast(float, __builtin_amdgcn_ds_bpermute((lane_id_() ^ o) << 2, __builtin_bit_cast(int, v))); }
template <int CTRL> __device__ __forceinline__ float dppf(float v) { return __builtin_bit_cast(float, __builtin_amdgcn_update_dpp(0, __builtin_bit_cast(int, v), CTRL, 0xF, 0xF, false)); }
__device__ __forceinline__ float nbr1(float v) { return dppf<0xB1>(v); }
__device__ __forceinline__ float sum32(float v) {
    v += dppf<0xB1>(v); v += dppf<0x4E>(v); v += dppf<0x141>(v); v += dppf<0x140>(v);
    auto rr = __builtin_amdgcn_permlane16_swap(__float_as_uint(v), __float_as_uint(v), false, false);
    return __uint_as_float(rr[0]) + __uint_as_float(rr[1]); }
__device__ __forceinline__ float max32(float v) {
    v = fmaxf(v, dppf<0xB1>(v)); v = fmaxf(v, dppf<0x4E>(v)); v = fmaxf(v, dppf<0x141>(v)); v = fmaxf(v, dppf<0x140>(v));
    auto rr = __builtin_amdgcn_permlane16_swap(__float_as_uint(v), __float_as_uint(v), false, false);
    return fmaxf(__uint_as_float(rr[0]), __uint_as_float(rr[1])); }
__device__ __forceinline__ float wave_sum(float v) {
    v = sum32(v);
    auto rr = __builtin_amdgcn_permlane32_swap(__float_as_uint(v), __float_as_uint(v), false, false);
    return __uint_as_float(rr[0]) + __uint_as_float(rr[1]); }
__device__ __forceinline__ float wave_max(float v) {
    v = max32(v);
    auto rr = __builtin_amdgcn_permlane32_swap(__float_as_uint(v), __float_as_uint(v), false, false);
    return fmaxf(__uint_as_float(rr[0]), __uint_as_float(rr[1])); }
__device__ __forceinline__ float sigmoidf_(float x) { return __builtin_amdgcn_rcpf(1.f + __builtin_amdgcn_exp2f(-1.4426950408889634f * x)); }
__device__ __forceinline__ int t5_bucket(int n) {
    if (n < 16) return n;
    int large = 16 + (int)(logf((float)n / 16.f) / 2.0794415416798357f * 16.f);
    return large < 31 ? large : 31;
}
__device__ __forceinline__ unsigned f2bf(float f) { unsigned u = __builtin_bit_cast(unsigned, f); return (u + 0x7fffu + ((u >> 16) & 1u)) >> 16; }
__device__ __forceinline__ unsigned pk2(float lo, float hi) { unsigned r; asm("v_cvt_pk_bf16_f32 %0, %1, %2" : "=v"(r) : "v"(lo), "v"(hi)); return r; }
__device__ __forceinline__ float bf2f(bf16 v) { return __builtin_bit_cast(float, (unsigned)v << 16); }
__device__ __forceinline__ unsigned cvt_pk_bf16(float lo, float hi) { unsigned r; asm volatile("v_cvt_pk_bf16_f32 %0, %1, %2" : "=v"(r) : "v"(lo), "v"(hi)); return r; }
#define LDS_WAIT() asm volatile("s_waitcnt lgkmcnt(0)" ::: "memory")
#define VM_WAIT() asm volatile("s_waitcnt vmcnt(0)" ::: "memory")

namespace pg8 {
constexpr int BM = 256, BK = 64, HALF = 128, HTB = HALF * BK * 2  , STAGE_BYTES = 8 * HTB, NXCD = 8, WGM = 8;
__host__ __device__ __forceinline__ int lds_byte(int r, int c) { const int st = (r >> 4) * 2 + (c >> 5), rr = r & 15, cc = c & 31, ob = rr * 64 + cc * 2; return st * 1024 + (ob ^ (((ob >> 9) & 1) << 5)); }
__host__ __device__ __forceinline__ void stage_rc(int b, int& R, int& C) { const int st = b / 1024, sb = b % 1024, swz = sb ^ (((sb >> 9) & 1) << 5); R = (st >> 1) * 16 + swz / 64; C = (st & 1) * 32 + (swz % 64) / 2; }
__host__ __device__ __forceinline__ int perm32(int rho) { const int n = rho >> 4, i = rho & 15; return 8 * (i >> 2) + 4 * n + (i & 3); }

struct Unit { int pm, pn, e, li; };

struct DenseOrder {
    const bf16* A; const bf16* Bt; int K, lda;
    int nM, nN, nwg, G, c;
    unsigned* ready = nullptr; unsigned need = 0; unsigned* tmo = nullptr;
    __device__ __forceinline__ void init(const bf16* A_, const bf16* Bt_, int M, int N, int K_, int G_, int c_) { A = A_; Bt = Bt_; K = K_; lda = K_; nM = M / BM; nN = N / BM; nwg = nM * nN; G = G_; c = c_; }
    __device__ __forceinline__ bool next(int i, Unit& u) const {
        const long L = (long)i * G + c; if (L >= nwg) return false;
        int wgid = (int)L; { const int q = nwg / NXCD, r = nwg % NXCD, xcd = wgid % NXCD, off = wgid / NXCD; wgid = (xcd < r ? xcd * (q + 1) : r * (q + 1) + (xcd - r) * q) + off; }
        const int nig = WGM * nN, gid = wgid / nig, fm = gid * WGM, gsz = (nM - fm) < WGM ? (nM - fm) : WGM;
        u.pm = fm + ((wgid % nig) % gsz); u.pn = (wgid % nig) / gsz; u.e = 0; u.li = i; return true;
    }
    __device__ __forceinline__ const char* a_tile(const Unit& u) const { return (const char*)A + (size_t)u.pm * BM * lda * 2; }
    __device__ __forceinline__ const char* b_tile(const Unit& u) const { return (const char*)Bt + (size_t)u.pn * BM * K * 2; }
    __device__ __forceinline__ const LAS int* a_rows(const Unit&) const { return nullptr; }
    __device__ __forceinline__ void a_ready(const Unit& u) const {
        if (ready == nullptr) return;
        if (tidx() < 64) {
            unsigned sp = 0;
            while ((unsigned)__builtin_amdgcn_readfirstlane(__hip_atomic_load(ready + 16 * u.pm, __ATOMIC_RELAXED, __HIP_MEMORY_SCOPE_AGENT)) < need) {
                __builtin_amdgcn_s_sleep(2);
                if ((++sp & 255u) == 0u) { if (__hip_atomic_load(tmo, __ATOMIC_RELAXED, __HIP_MEMORY_SCOPE_AGENT)) break; if (sp > (1u << 18)) { if (tidx() == 0) atomicAdd(tmo, 1u); break; } } }
            __builtin_amdgcn_fence(__ATOMIC_ACQUIRE, "agent");
            asm volatile("s_waitcnt vmcnt(0)" ::: "memory");
        }
        asm volatile("" ::: "memory"); __builtin_amdgcn_s_barrier(); asm volatile("" ::: "memory");
    }
};

#define PG8_LAS LAS
template <class Epi, class Sched, bool GATHER>
__device__ __forceinline__ void gemm_phase(PG8_LAS unsigned char* lds, const Sched& S, const Epi& E) {
    const int tid = tidx(), wid = __builtin_amdgcn_readfirstlane(tid >> 6), lane = tid & 63, wr = wid >> 2, wc = wid & 3, fr = lane & 15, fq = lane >> 4;
    const int K = S.K, nt = K / BK, lda = S.lda;
    unsigned voffA[2], voffB[2]; int rA[2], cA2[2];
#pragma unroll
    for (int i = 0; i < 2; ++i) { int R, C; stage_rc(tid * 16 + i * 8192, R, C); const int Rb = Epi::PERM ? ((R & ~31) + perm32(R & 31)) : R;
        rA[i] = R; cA2[i] = C * 2; voffA[i] = (unsigned)(R * lda + C) * 2u; voffB[i] = (unsigned)(Rb * K + C) * 2u; }
    const size_t kstep = (size_t)(BK * 2);
    const size_t hstep = (size_t)HALF * K * 2, hstepA = (size_t)HALF * lda * 2;
    const unsigned ldsw = (unsigned)wid * 1024u;
    const int aoff = lds_byte(wr * 64 + fr, fq * 8), boff = lds_byte(wc * 32 + fr, fq * 8);
#define PG8_SA(b, h) (((b) * 2 + (h)) * HTB)
#define PG8_SB(b, h) ((4 + (b) * 2 + (h)) * HTB)
#define PG8_STAGE(bufoff, gbase, voff) do { _Pragma("unroll") for (int _i = 0; _i < 2; ++_i) \
        __builtin_amdgcn_global_load_lds((const unsigned*)((const char*)(gbase) + (voff)[_i]), (PG8_LAS unsigned*)(lds + (bufoff) + ldsw + _i * 8192), 16, 0, 0); } while (0)
#define PG8_STAGE_A(bufoff, ptr, h, VO) do { if constexpr (GATHER) { PG8_STAGE(bufoff, ptr, VO[h]); } else { PG8_STAGE(bufoff, (ptr) + (h) * hstepA, voffA); } } while (0)
#define PG8_LDA(dst, b, h) do { _Pragma("unroll") for (int m = 0; m < 4; ++m) _Pragma("unroll") for (int k = 0; k < 2; ++k) dst[m][k] = *(const PG8_LAS bf16x8*)(lds + PG8_SA(b, h) + aoff + m * 2048 + k * 1024); } while (0)
#define PG8_LDB(dst, b, h) do { _Pragma("unroll") for (int n = 0; n < 2; ++n) _Pragma("unroll") for (int k = 0; k < 2; ++k) dst[n][k] = *(const PG8_LAS bf16x8*)(lds + PG8_SB(b, h) + boff + n * 2048 + k * 1024); } while (0)
#define PG8_MMA(ai, bj, At, Bt) do { __builtin_amdgcn_s_setprio(1); _Pragma("unroll") for (int m = 0; m < 4; ++m) _Pragma("unroll") for (int n = 0; n < 2; ++n) _Pragma("unroll") for (int k = 0; k < 2; ++k) \
        acc[ai][bj][m][n] = __builtin_amdgcn_mfma_f32_16x16x32_bf16(Bt[n][k], At[m][k], acc[ai][bj][m][n], 0, 0, 0); __builtin_amdgcn_s_setprio(0); } while (0)
#define PG8_WAIT_V(n) asm volatile("s_waitcnt vmcnt(" #n ")" ::: "memory")
#define PG8_WAIT_L(n) asm volatile("s_waitcnt lgkmcnt(" #n ")" ::: "memory")
#define PG8_BAR __builtin_amdgcn_s_barrier()
#define PG8_SCHED __builtin_amdgcn_sched_barrier(0)
    Unit cur, nxt;
    if (!S.next(0, cur)) return;
    f32x4 acc[2][2][4][2];
    float z0 = 0.f; asm volatile("" : "+v"(z0));
#pragma unroll
    for (int a = 0; a < 2; ++a)
#pragma unroll
        for (int b = 0; b < 2; ++b)
#pragma unroll
            for (int m = 0; m < 4; ++m)
#pragma unroll
                for (int n = 0; n < 2; ++n) acc[a][b][m][n] = (f32x4){z0, z0, z0, z0};
    bf16x8 At[4][2], B0[2][2], B1[2][2];
    unsigned cvo[2][2], nvo[2][2], tvo[2][2];
    const char* cA = S.a_tile(cur); const char* cB = S.b_tile(cur);
    S.a_ready(cur);
    if constexpr (GATHER) { const PG8_LAS int* rw = S.a_rows(cur);
#pragma unroll
        for (int h = 0; h < 2; ++h)
#pragma unroll
            for (int i = 0; i < 2; ++i) cvo[h][i] = (unsigned)rw[h * HALF + rA[i]] * (unsigned)(lda * 2) + (unsigned)cA2[i]; }
    PG8_STAGE(PG8_SB(0, 0), cB, voffB); PG8_STAGE(PG8_SB(0, 1), cB + hstep, voffB); PG8_STAGE_A(PG8_SA(0, 0), cA, 0, cvo); PG8_STAGE_A(PG8_SA(0, 1), cA, 1, cvo);
    if (wr == 1) PG8_BAR;
    PG8_WAIT_V(2); PG8_BAR;
    PG8_STAGE(PG8_SB(1, 0), cB + kstep, voffB); PG8_STAGE_A(PG8_SA(1, 0), cA + kstep, 0, cvo); PG8_STAGE(PG8_SB(1, 1), cB + hstep + kstep, voffB);
    PG8_WAIT_V(6); PG8_BAR;
    int ui = 0;
    for (;;) {
        const bool has_next = S.next(ui + 1, nxt);
        const char* nA = has_next ? S.a_tile(nxt) : cA; const char* nB = has_next ? S.b_tile(nxt) : cB;
        if constexpr (GATHER) {
            if (has_next) { const PG8_LAS int* rw = S.a_rows(nxt);
#pragma unroll
                for (int h = 0; h < 2; ++h)
#pragma unroll
                    for (int i = 0; i < 2; ++i) nvo[h][i] = (unsigned)rw[h * HALF + rA[i]] * (unsigned)(lda * 2) + (unsigned)cA2[i]; }
            else {
#pragma unroll
                for (int h = 0; h < 2; ++h)
#pragma unroll
                    for (int i = 0; i < 2; ++i) nvo[h][i] = cvo[h][i]; }
        }
        for (int t = 0; t < nt; t += 2) {
            const bool last = (t == nt - 2);
            const char* a1 = cA + (size_t)(t + 1) * kstep;
            const char* a2 = last ? nA : cA + (size_t)(t + 2) * kstep; const char* b2 = last ? nB : cB + (size_t)(t + 2) * kstep;
            const char* a3 = a2 + kstep; const char* b3 = b2 + kstep;
            if (last && has_next) S.a_ready(nxt);
            if constexpr (GATHER) {
#pragma unroll
                for (int h = 0; h < 2; ++h)
#pragma unroll
                    for (int i = 0; i < 2; ++i) tvo[h][i] = last ? nvo[h][i] : cvo[h][i]; }
            PG8_LDB(B0, 0, 0); PG8_LDB(B1, 0, 1); PG8_SCHED; PG8_LDA(At, 0, 0); PG8_STAGE_A(PG8_SA(1, 1), a1, 1, cvo);
            PG8_WAIT_V(8); PG8_WAIT_L(0); PG8_BAR; PG8_MMA(0, 0, At, B0); PG8_MMA(0, 1, At, B1); PG8_BAR; PG8_SCHED;
            PG8_LDA(At, 0, 1); PG8_STAGE(PG8_SB(0, 0), b2, voffB); PG8_STAGE(PG8_SB(0, 1), b2 + hstep, voffB); PG8_STAGE_A(PG8_SA(0, 0), a2, 0, tvo);
            PG8_WAIT_V(8); PG8_WAIT_L(0); PG8_BAR; PG8_MMA(1, 0, At, B0); PG8_MMA(1, 1, At, B1); PG8_BAR; PG8_SCHED;
            PG8_LDB(B0, 1, 0); PG8_LDB(B1, 1, 1); PG8_SCHED; PG8_LDA(At, 1, 0); PG8_STAGE_A(PG8_SA(0, 1), a2, 1, tvo);
            PG8_WAIT_V(8); PG8_WAIT_L(0); PG8_BAR; PG8_MMA(0, 0, At, B0); PG8_MMA(0, 1, At, B1); PG8_BAR; PG8_SCHED;
            PG8_LDA(At, 1, 1); PG8_STAGE(PG8_SB(1, 0), b3, voffB); PG8_STAGE(PG8_SB(1, 1), b3 + hstep, voffB); PG8_STAGE_A(PG8_SA(1, 0), a3, 0, tvo);
            PG8_WAIT_V(8); PG8_WAIT_L(0); PG8_BAR; PG8_MMA(1, 0, At, B0); PG8_MMA(1, 1, At, B1); PG8_BAR; PG8_SCHED;
        }
        if (wr == 0) PG8_BAR;
        E(acc, cur, wr, wc, fr, fq);
        if (!has_next) break;
#pragma unroll
        for (int a = 0; a < 2; ++a)
#pragma unroll
            for (int b = 0; b < 2; ++b)
#pragma unroll
                for (int m = 0; m < 4; ++m)
#pragma unroll
                    for (int n = 0; n < 2; ++n) acc[a][b][m][n] = (f32x4){z0, z0, z0, z0};
        cur = nxt; cA = nA; cB = nB; ++ui;
        if constexpr (GATHER) {
#pragma unroll
            for (int h = 0; h < 2; ++h)
#pragma unroll
                for (int i = 0; i < 2; ++i) cvo[h][i] = nvo[h][i]; }
        if (wr == 1) PG8_BAR;
    }
    PG8_WAIT_V(0);
    PG8_BAR;
#undef PG8_SA
#undef PG8_SB
#undef PG8_STAGE
#undef PG8_STAGE_A
#undef PG8_LDA
#undef PG8_LDB
#undef PG8_MMA
#undef PG8_WAIT_V
#undef PG8_WAIT_L
#undef PG8_BAR
#undef PG8_SCHED
}
}

constexpr int NWAVES = 8, NTHR = 512;
constexpr int RING_BYTES = 131072, LDS_BYTES = 147456;
constexpr int MISC_OFF = RING_BYTES;

struct Args {
    const float* in[25];
    float* out;
    unsigned char* ws;
    unsigned* ctl;
    bf16* win_t;
    bf16* wout_t;
    float* hres;
    bf16* hb;
    float* rstd;
    bf16* qb; bf16* kb; bf16* vb;
    bf16* ug;
    bf16* hq; bf16* hk; bf16* hv; bf16* hg;
    float* hlogf;
    float* lbt;
    bf16* mixb;
    bf16* wgu_t;
    bf16* wd_t;
    int* tokl;
    float* gl;
    int* sl;
    bf16* hmid;
    bf16* ybuf;
    bf16* s5et;
    bf16* s5mf;
    float* s5a32;
    float* xend;
    bf16* zb;
    bf16* wglu_t;
    bf16* hub;
    float* hdb;
    bf16* hsp;
    bf16* wrh;
    bf16* wrl;
};

struct KArgs { const float* in[25]; float* out; unsigned char* ws; int pi0, nprog; };
constexpr size_t MiBc = (size_t)1 << 20;
constexpr size_t rup(size_t x) { return (x + MiBc - 1) & ~(MiBc - 1); }
constexpr size_t O_CTL = 0;
constexpr size_t O_WIN = O_CTL + rup(MiBc);
constexpr size_t O_WOUT = O_WIN + rup((size_t)DEPTH * INCP * DM * 2);
constexpr size_t O_HRES = O_WOUT + rup((size_t)DEPTH * DM * DM * 2);
constexpr size_t O_HB = O_HRES + rup((size_t)T * DM * 4);
constexpr size_t O_RSTD = O_HB + rup((size_t)T * DM * 2);
constexpr size_t O_QKV = O_RSTD + rup((size_t)T * 4);
constexpr size_t O_UG = O_QKV + rup((size_t)3 * T * AW * 2);
constexpr size_t O_HQ = O_UG + rup((size_t)SG * 256 * S5LD * 2);
constexpr size_t O_HLOGF = O_HQ + rup((size_t)4 * T * HW * 2);
constexpr size_t O_LBT = O_HLOGF + rup((size_t)T * HW * 4);
constexpr size_t O_MIXB = O_LBT + rup((size_t)DEPTH * HW * 2 * 4);
constexpr size_t O_WGU = O_MIXB + rup((size_t)T * DM * 2);
constexpr size_t O_WD = O_WGU + rup((size_t)DEPTH * NE * 1024 * DM * 2);
constexpr size_t O_TOKL = O_WD + rup((size_t)DEPTH * NE * DM * DE * 2);
constexpr size_t O_GL = O_TOKL + rup((size_t)NE * T * 4);
constexpr size_t O_SL = O_GL + rup((size_t)NE * T * 4);
constexpr size_t O_S5ET = O_SL + rup((size_t)T * 2 * 4);
constexpr size_t O_S5MF = O_S5ET + rup((size_t)DEPTH * SG * 256 * 512 * 2);
constexpr size_t O_S5A32 = O_S5MF + rup((size_t)DEPTH * SG * 512 * 640 * 2);
constexpr size_t O_XEND = O_S5A32 + rup((size_t)DEPTH * SG * 64 * 2 * 4);
constexpr size_t O_ZB = O_XEND + rup((size_t)SG * 128 * 256 * 4);
constexpr size_t O_WGLU = O_ZB + rup((size_t)T * SW * 2);
constexpr size_t O_HUB = O_WGLU + rup((size_t)DEPTH * 768 * SW * 2);
constexpr size_t O_HDB = O_HUB + rup((size_t)640 * HD * HD * 2);
constexpr size_t O_HSP = O_HDB + rup((size_t)640 * HD * 4);
constexpr size_t O_WRH = O_HSP + rup((size_t)640 * HD * HD * 2);
constexpr size_t O_WRL = O_WRH + rup((size_t)DEPTH * 64 * DM * 2);
constexpr size_t O_YBUF = O_WRL + rup((size_t)DEPTH * 64 * DM * 2);
constexpr size_t O_HMID = O_YBUF + rup((size_t)96 * 256 * DM * 2);
constexpr size_t O_END = O_HMID + rup((size_t)96 * 256 * DE * 2);
__host__ __device__ __forceinline__ void fill_ws(Args& a, unsigned char* ws) {
    a.ws = ws; a.ctl = (unsigned*)(ws + O_CTL); a.win_t = (bf16*)(ws + O_WIN); a.wout_t = (bf16*)(ws + O_WOUT); a.hres = (float*)(ws + O_HRES); a.hb = (bf16*)(ws + O_HB);
    a.rstd = (float*)(ws + O_RSTD); a.qb = (bf16*)(ws + O_QKV); a.kb = a.qb + (size_t)T * AW; a.vb = a.kb + (size_t)T * AW; a.ug = (bf16*)(ws + O_UG);
    a.hq = (bf16*)(ws + O_HQ); a.hk = a.hq + (size_t)T * HW; a.hv = a.hk + (size_t)T * HW; a.hg = a.hv + (size_t)T * HW; a.hlogf = (float*)(ws + O_HLOGF);
    a.lbt = (float*)(ws + O_LBT); a.mixb = (bf16*)(ws + O_MIXB); a.wgu_t = (bf16*)(ws + O_WGU); a.wd_t = (bf16*)(ws + O_WD); a.tokl = (int*)(ws + O_TOKL);
    a.gl = (float*)(ws + O_GL); a.sl = (int*)(ws + O_SL); a.s5et = (bf16*)(ws + O_S5ET); a.s5mf = (bf16*)(ws + O_S5MF); a.s5a32 = (float*)(ws + O_S5A32);
    a.xend = (float*)(ws + O_XEND); a.zb = (bf16*)(ws + O_ZB); a.wglu_t = (bf16*)(ws + O_WGLU); a.hub = (bf16*)(ws + O_HUB); a.hdb = (float*)(ws + O_HDB);
    a.hsp = (bf16*)(ws + O_HSP); a.wrh = (bf16*)(ws + O_WRH); a.wrl = (bf16*)(ws + O_WRL); a.ybuf = (bf16*)(ws + O_YBUF); a.hmid = (bf16*)(ws + O_HMID);
}

struct TrItem { const float* src; const float* ks; bf16* dst; int N, K; };
template <bool SC>
__device__ __forceinline__ void tr_load(const TrItem& t, f32x4 (&v)[8], float (&sc)[8], int lane) {
    const int kr = lane >> 3, n4 = lane & 7;
#pragma unroll
    for (int i = 0; i < 8; ++i) v[i] = __builtin_nontemporal_load((const GAS f32x4*)(t.src + (size_t)(8 * i + kr) * t.N + 4 * n4));
    if constexpr (SC) {
#pragma unroll
        for (int i = 0; i < 8; ++i) sc[i] = *(const GAS float*)(t.ks + 8 * i + kr);
    }
}
template <bool SC>
__device__ __forceinline__ void tr_finish(const TrItem& t, f32x4 (&v)[8], float (&sc)[8], LAS float* scr, int lane) {
    const int kr = lane >> 3, n4 = lane & 7;
#pragma unroll
    for (int i = 0; i < 8; ++i) { const int kk = 8 * i + kr; f32x4 x = v[i]; if constexpr (SC) x = x * sc[i];
        LAS float* d = scr + kk * 33 + 4 * n4; d[0] = x[0]; d[1] = x[1]; d[2] = x[2]; d[3] = x[3]; }
    LDS_WAIT(); asm volatile("" ::: "memory");
    const int c = lane & 7;
#pragma unroll
    for (int j = 0; j < 4; ++j) { const int n = (lane >> 3) + 8 * j; const LAS float* sp = scr + (8 * c) * 33 + n;
        v4u o; o.x = pk2(sp[0 * 33], sp[1 * 33]); o.y = pk2(sp[2 * 33], sp[3 * 33]); o.z = pk2(sp[4 * 33], sp[5 * 33]); o.w = pk2(sp[6 * 33], sp[7 * 33]);
        __builtin_nontemporal_store(o, (GAS v4u*)(t.dst + (size_t)n * t.K + 8 * c)); }
    LDS_WAIT(); asm volatile("" ::: "memory");
}
template <bool SC, class F>
__device__ __forceinline__ void tr_loop(const F& mk, int nitems, int gw, int NGW, LAS float* scr, int lane) {
    if (gw >= nitems) return;
    const int nit = (nitems - gw + NGW - 1) / NGW, last = nit - 1;
    TrItem c0 = mk(gw), c1 = mk(gw + (1 < last ? 1 : last) * NGW), c2 = c0; f32x4 v0[8], v1[8], v2[8]; float s0[8], s1[8], s2[8];
    tr_load<SC>(c0, v0, s0, lane);
    tr_load<SC>(c1, v1, s1, lane);
    for (int i = 0; ; i += 3) {
        c2 = mk(gw + (i + 2 < last ? i + 2 : last) * NGW); tr_load<SC>(c2, v2, s2, lane);
        tr_finish<SC>(c0, v0, s0, scr, lane);
        if (i + 1 >= nit) break;
        c0 = mk(gw + (i + 3 < last ? i + 3 : last) * NGW); tr_load<SC>(c0, v0, s0, lane);
        tr_finish<SC>(c1, v1, s1, scr, lane);
        if (i + 2 >= nit) break;
        c1 = mk(gw + (i + 4 < last ? i + 4 : last) * NGW); tr_load<SC>(c1, v1, s1, lane);
        tr_finish<SC>(c2, v2, s2, scr, lane);
        if (i + 3 >= nit) break;
    }
}
struct MkIn {
    const float* win; const float* g; bf16* win_t; int off;
    __device__ __forceinline__ TrItem operator()(int it0) const {
        constexpr int I_IN = (DM / 64) * (INC / 32);
        const int it = it0 + off, ll = it / I_IN, r = it % I_IN, kb = r / (INC / 32), nb = r % (INC / 32), k0 = 64 * kb, n0 = 32 * nb; TrItem t;
        t.src = win + (size_t)ll * DM * INC + (size_t)k0 * INC + n0; t.ks = g + ll * DM + k0; t.dst = win_t + (size_t)ll * INCP * DM + (size_t)n0 * DM + k0; t.N = INC; t.K = DM;
        return t; }
};
struct MkOut {
    const float* wout; bf16* wout_t; int off;
    __device__ __forceinline__ TrItem operator()(int it0) const {
        constexpr int I_OUT = (DM / 64) * (DM / 32);
        const int it = it0 + off, ll = it / I_OUT, q = it % I_OUT, kb = q / (DM / 32), nb = q % (DM / 32), k0 = 64 * kb, n0 = 32 * nb; TrItem t;
        t.src = wout + (size_t)ll * DM * DM + (size_t)k0 * DM + n0; t.ks = nullptr; t.dst = wout_t + (size_t)ll * DM * DM + (size_t)n0 * DM + k0; t.N = DM; t.K = DM;
        return t; }
};
struct MkGlu {
    const float* w; bf16* wt;
    __device__ __forceinline__ TrItem operator()(int it) const {
        constexpr int I_GL = (SW / 64) * (SW / 32);
        const int ll = it / I_GL, r = it % I_GL, kb = r / (SW / 32), nb = r % (SW / 32), k0 = 64 * kb, n0 = 32 * nb; TrItem t;
        t.src = w + (size_t)ll * SW * SW + (size_t)k0 * SW + n0; t.ks = nullptr; t.dst = wt + (size_t)ll * 768 * SW + (size_t)n0 * SW + k0; t.N = SW; t.K = SW; return t; }
};
struct MkMoeGU {
    const float* wg; const float* wu; const float* g; bf16* wgu_t; int off;
    __device__ __forceinline__ TrItem operator()(int it0) const {
        constexpr int I_G = (DM / 64) * (DE / 32);
        const int it = off < 0 ? (-off - 1 - it0) : it0 + off, le = it / (2 * I_G), r = it % (2 * I_G), ll = le / NE; TrItem t;
        const int up = r / I_G, q = r % I_G, kb = q / (DE / 32), nb = q % (DE / 32), k0 = 64 * kb, n0 = 32 * nb;
        const int d0 = (n0 >> 7) * 256 + up * 128 + (n0 & 127);
        t.src = (up ? wu : wg) + (size_t)le * DM * DE + (size_t)k0 * DE + n0; t.ks = g + ll * DM + k0; t.dst = wgu_t + (size_t)le * 1024 * DM + (size_t)d0 * DM + k0; t.N = DE; t.K = DM;
        return t; }
};
struct MkMoeD {
    const float* wd; bf16* wd_t; int off;
    __device__ __forceinline__ TrItem operator()(int it0) const {
        constexpr int I_D = (DE / 64) * (DM / 32);
        const int it = off < 0 ? (-off - 1 - it0) : it0 + off, le = it / I_D, q = it % I_D, kb = q / (DM / 32), nb = q % (DM / 32), k0 = 64 * kb, n0 = 32 * nb; TrItem t;
        t.src = wd + (size_t)le * DE * DM + (size_t)k0 * DM + n0; t.ks = nullptr; t.dst = wd_t + (size_t)le * DM * DE + (size_t)n0 * DE + k0; t.N = DM; t.K = DE;
        return t; }
};
__device__ __forceinline__ void stats_row(const float* xrow, bf16* orow, float* rstd_out, int lane) {
    const GAS f32x4* xr = (const GAS f32x4*)xrow + lane;
    f32x4 v[8]; float s = 0.f;
#pragma unroll
    for (int j = 0; j < 8; ++j) { v[j] = xr[64 * j]; s += (v[j].x * v[j].x + v[j].y * v[j].y) + (v[j].z * v[j].z + v[j].w * v[j].w); }
    s = wave_sum(s);
    if (lane == 0) *rstd_out = 1.0f / sqrtf(s * (1.f / DM) + EPS);
    GAS v2u* o8 = (GAS v2u*)orow + lane;
#pragma unroll
    for (int j = 0; j < 8; ++j) { v2u w; w.x = pk2(v[j].x, v[j].y); w.y = pk2(v[j].z, v[j].w); o8[64 * j] = w; }
}

struct EpiProj {
    static constexpr bool PERM = true;
    const float* rstd; bf16 *qb, *kb, *vb, *ug, *hq, *hk, *hv, *hg; float* hlogf; const float* lbt;
    template <int bj>
    __device__ __forceinline__ void half(const f32x4 (&acc)[2][2][4][2], const float (&rs)[2][4], int hc, int row0, int cin) const {
        if (hc >= 43) return;
        if (hc < 18) {
            bf16* base = qb + (size_t)(hc / 6) * ((size_t)T * AW); const int c0 = (hc % 6) * 128 + cin;
#pragma unroll
            for (int ai = 0; ai < 2; ++ai)
#pragma unroll
                for (int m = 0; m < 4; ++m) { const int row = row0 + ai * 128 + m * 16; const float r = rs[ai][m];
                    const f32x4 a = acc[ai][bj][m][0] * r, b = acc[ai][bj][m][1] * r;
                    v4u w; w.x = cvt_pk_bf16(a[0], a[1]); w.y = cvt_pk_bf16(a[2], a[3]); w.z = cvt_pk_bf16(b[0], b[1]); w.w = cvt_pk_bf16(b[2], b[3]);
                    *(v4u*)(base + (size_t)row * AW + c0) = w; }
        } else if (hc < 23) {
            const int ch = (hc - 18) * 128 + cin, g = ch >> 4, c = ch & 15;
#pragma unroll
            for (int ai = 0; ai < 2; ++ai)
#pragma unroll
                for (int m = 0; m < 4; ++m) { const int row = row0 + ai * 128 + m * 16; const float r = rs[ai][m];
                    const f32x4 a = acc[ai][bj][m][0] * r, b = acc[ai][bj][m][1] * r;
                    v4u w; w.x = cvt_pk_bf16(a[0], a[1]); w.y = cvt_pk_bf16(a[2], a[3]); w.z = cvt_pk_bf16(b[0], b[1]); w.w = cvt_pk_bf16(b[2], b[3]);
                    *(v4u*)(ug + ((size_t)g * 256 + (row >> 5)) * S5LD + (row & 31) * SC + c) = w; }
        } else {
            const int kind = (hc - 23) / 5, ch = ((hc - 23) % 5) * 128 + cin;
            if (kind == 1) {
                float lbv[8], omv[8];
#pragma unroll
                for (int j = 0; j < 8; ++j) { lbv[j] = lbt[(ch + j) * 2]; omv[j] = lbt[(ch + j) * 2 + 1]; }
#pragma unroll
                for (int ai = 0; ai < 2; ++ai)
#pragma unroll
                    for (int m = 0; m < 4; ++m) { const int row = row0 + ai * 128 + m * 16; const float r = rs[ai][m];
                        const f32x4 a = acc[ai][bj][m][0] * r, b = acc[ai][bj][m][1] * r;
                        const float v[8] = {a[0], a[1], a[2], a[3], b[0], b[1], b[2], b[3]};
                        float lf[8], kk[8];
#pragma unroll
                        for (int j = 0; j < 8; ++j) {
                            const float x = fmaxf(v[j], -80.f), e = __builtin_amdgcn_exp2f(-1.4426950408889634f * x), sg = __builtin_amdgcn_rcpf(1.f + e);
                            lf[j] = __builtin_amdgcn_logf(fmaf(omv[j], sg, lbv[j])) * 0.6931471805599453f; kk[j] = omv[j] * e * sg; }
                        *(f32x4*)(hlogf + (size_t)row * HW + ch) = (f32x4){lf[0], lf[1], lf[2], lf[3]};
                        *(f32x4*)(hlogf + (size_t)row * HW + ch + 4) = (f32x4){lf[4], lf[5], lf[6], lf[7]};
                        v4u w; w.x = cvt_pk_bf16(kk[0], kk[1]); w.y = cvt_pk_bf16(kk[2], kk[3]); w.z = cvt_pk_bf16(kk[4], kk[5]); w.w = cvt_pk_bf16(kk[6], kk[7]);
                        *(v4u*)(hk + (size_t)row * HW + ch) = w; }
            } else {
                bf16* base = hq + (size_t)kind * ((size_t)T * HW);
#pragma unroll
                for (int ai = 0; ai < 2; ++ai)
#pragma unroll
                    for (int m = 0; m < 4; ++m) { const int row = row0 + ai * 128 + m * 16; const float r = rs[ai][m];
                        const f32x4 a = acc[ai][bj][m][0] * r, b = acc[ai][bj][m][1] * r;
                        float v[8] = {a[0], a[1], a[2], a[3], b[0], b[1], b[2], b[3]};
                        if (kind == 0) {
#pragma unroll
                            for (int j = 0; j < 8; ++j) v[j] = v[j] * sigmoidf_(v[j]) * 0.08838834764831845f;
                        } else if (kind == 3) {
#pragma unroll
                            for (int j = 0; j < 8; ++j) v[j] = sigmoidf_(v[j]);
                        }
                        v4u w; w.x = cvt_pk_bf16(v[0], v[1]); w.y = cvt_pk_bf16(v[2], v[3]); w.z = cvt_pk_bf16(v[4], v[5]); w.w = cvt_pk_bf16(v[6], v[7]);
                        *(v4u*)(base + (size_t)row * HW + ch) = w; }
            }
        }
    }
    __device__ __forceinline__ void operator()(const f32x4 (&acc)[2][2][4][2], const pg8::Unit& u, int wr, int wc, int fr, int fq) const {
        const int row0 = u.pm * 256 + wr * 64 + fr, cin = wc * 32 + 8 * fq;
        float rs[2][4];
#pragma unroll
        for (int ai = 0; ai < 2; ++ai)
#pragma unroll
            for (int m = 0; m < 4; ++m) rs[ai][m] = rstd[row0 + ai * 128 + m * 16];
        half<0>(acc, rs, 2 * u.pn, row0, cin);
        half<1>(acc, rs, 2 * u.pn + 1, row0, cin);
    }
};
struct EpiResid {
    static constexpr bool PERM = true;
    bf16* hb; unsigned* ready;
    __device__ __forceinline__ void operator()(const f32x4 (&acc)[2][2][4][2], const pg8::Unit& u, int wr, int wc, int fr, int fq) const {
        const int row0 = u.pm * 256 + wr * 64 + fr, col0 = u.pn * 256 + wc * 32 + 8 * fq;
#pragma unroll
        for (int ai = 0; ai < 2; ++ai)
#pragma unroll
            for (int m = 0; m < 4; ++m) { bf16* rp = hb + (size_t)(row0 + ai * 128 + m * 16) * DM + col0;
#pragma unroll
                for (int bj = 0; bj < 2; ++bj) { const v4u r = *(const v4u*)(rp + bj * 128); const f32x4 a = acc[ai][bj][m][0], b = acc[ai][bj][m][1];
                    v4u w;
                    w.x = cvt_pk_bf16(__builtin_bit_cast(float, r.x << 16) + a[0], __builtin_bit_cast(float, r.x & 0xffff0000u) + a[1]);
                    w.y = cvt_pk_bf16(__builtin_bit_cast(float, r.y << 16) + a[2], __builtin_bit_cast(float, r.y & 0xffff0000u) + a[3]);
                    w.z = cvt_pk_bf16(__builtin_bit_cast(float, r.z << 16) + b[0], __builtin_bit_cast(float, r.z & 0xffff0000u) + b[1]);
                    w.w = cvt_pk_bf16(__builtin_bit_cast(float, r.w << 16) + b[2], __builtin_bit_cast(float, r.w & 0xffff0000u) + b[3]);
                    bf16* dp = rp + bj * 128;
                    asm volatile("global_store_dwordx4 %0, %1, off sc1\n\ts_nop 1" :: "v"(dp), "v"(w) : "memory"); } }
        asm volatile("s_waitcnt vmcnt(0)" ::: "memory");
        if ((fr | fq) == 0) __hip_atomic_fetch_add(ready + 16 * u.pm, 1u, __ATOMIC_RELAXED, __HIP_MEMORY_SCOPE_AGENT);
    }
};

__device__ __forceinline__ unsigned xb_ld(unsigned* p);
#define XB_SPIN_CAP (1u << 18)
constexpr int CONV_S = 8192;
constexpr int MAXTILES = 96, MAXROWS = MAXTILES * 256, MAXUNITS = 8;
__device__ __forceinline__ int moe_rank(int bx, int lo, int G) {
    if (bx < lo) return -1;
    const int n = G - lo;
    if ((n & 7) || (lo & 7)) return bx - lo;
    return (bx & 7) * (n >> 3) + ((bx - lo) >> 3);
}
struct MoeOrder {
    const bf16* A; const bf16* Bt; int K, lda;
    size_t estride; int NP, G, c; bool gather;
    const LAS int* tpre; const LAS int* rowsl;
    unsigned* ready; unsigned need; unsigned* tmo;
    __device__ __forceinline__ bool next(int i, pg8::Unit& u) const {
        if (c < 0 || i >= MAXUNITS) return false;
        const int L = i * G + c; if (L >= tpre[NE] * NP) return false;
        int e = 0; while (tpre[e + 1] * NP <= L) ++e;
        const int r = L - tpre[e] * NP, mte = tpre[e + 1] - tpre[e];
        u.e = e; u.pn = r / mte; u.pm = tpre[e] + r % mte; u.li = i; return true;
    }
    __device__ __forceinline__ const char* a_tile(const pg8::Unit& u) const { return gather ? (const char*)A : (const char*)A + (size_t)u.pm * 256 * K * 2; }
    __device__ __forceinline__ const char* b_tile(const pg8::Unit& u) const { return (const char*)Bt + ((size_t)u.e * estride + (size_t)u.pn * 256 * K) * 2; }
    __device__ __forceinline__ const LAS int* a_rows(const pg8::Unit& u) const { return rowsl + u.li * 256; }
    __device__ __forceinline__ void a_ready(const pg8::Unit& u) const {
        if (ready == nullptr) return;
        if (tidx() < 64) {
            unsigned sp = 0;
            while ((unsigned)__builtin_amdgcn_readfirstlane(__hip_atomic_load(ready + 16 * u.pm, __ATOMIC_RELAXED, __HIP_MEMORY_SCOPE_AGENT)) < need) {
                __builtin_amdgcn_s_sleep(2);
                if ((++sp & 255u) == 0u) { if (xb_ld(tmo)) break; if (sp > XB_SPIN_CAP) { if (tidx() == 0) atomicAdd(tmo, 1u); break; } } }
            __builtin_amdgcn_fence(__ATOMIC_ACQUIRE, "agent");
            asm volatile("s_waitcnt vmcnt(0)" ::: "memory");
        }
        asm volatile("" ::: "memory"); __builtin_amdgcn_s_barrier(); asm volatile("" ::: "memory");
    }
};
struct EpiGU {
    static constexpr bool PERM = true;
    const float* rstd; bf16* hmid; const LAS int* rowsl; unsigned* ready;
    __device__ __forceinline__ void operator()(const f32x4 (&acc)[2][2][4][2], const pg8::Unit& u, int wr, int wc, int fr, int fq) const {
        const int rl0 = wr * 64 + fr, c0 = u.pn * 128 + wc * 32 + 8 * fq;
#pragma unroll
        for (int ai = 0; ai < 2; ++ai)
#pragma unroll
            for (int m = 0; m < 4; ++m) { const int rl = rl0 + ai * 128 + m * 16; const float r = rstd[rowsl[u.li * 256 + rl]];
                const f32x4 g0 = acc[ai][0][m][0] * r, g1 = acc[ai][0][m][1] * r, u0 = acc[ai][1][m][0] * r, u1 = acc[ai][1][m][1] * r;
                float v[8];
#pragma unroll
                for (int j = 0; j < 4; ++j) { v[j] = g0[j] * sigmoidf_(g0[j]) * u0[j]; v[4 + j] = g1[j] * sigmoidf_(g1[j]) * u1[j]; }
                v4u w; w.x = cvt_pk_bf16(v[0], v[1]); w.y = cvt_pk_bf16(v[2], v[3]); w.z = cvt_pk_bf16(v[4], v[5]); w.w = cvt_pk_bf16(v[6], v[7]);
                bf16* dst = hmid + (size_t)(u.pm * 256 + rl) * DE + c0;
                asm volatile("global_store_dwordx4 %0, %1, off sc1\n\ts_nop 1" :: "v"(dst), "v"(w) : "memory"); }
        asm volatile("s_waitcnt vmcnt(0)" ::: "memory");
        if (ready && (fr | fq) == 0) __hip_atomic_fetch_add(ready + 16 * u.pm, 1u, __ATOMIC_RELAXED, __HIP_MEMORY_SCOPE_AGENT);
    }
};
struct EpiDown {
    static constexpr bool PERM = true;
    const float* gl; const int* cnt; bf16* ybuf; const LAS int* tpre;
    __device__ __forceinline__ void operator()(const f32x4 (&acc)[2][2][4][2], const pg8::Unit& u, int wr, int wc, int fr, int fq) const {
        const int rl0 = wr * 64 + fr, col0 = u.pn * 256 + wc * 32 + 8 * fq;
        const int pos0 = (u.pm - tpre[u.e]) * 256, ce = cnt[u.e * 64];
#pragma unroll
        for (int ai = 0; ai < 2; ++ai)
#pragma unroll
            for (int m = 0; m < 4; ++m) { const int rl = rl0 + ai * 128 + m * 16, pos = pos0 + rl;
                if (pos < ce) { const float gt = gl[(size_t)u.e * T + pos]; bf16* yr = ybuf + (size_t)(u.pm * 256 + rl) * DM + col0;
#pragma unroll
                    for (int bj = 0; bj < 2; ++bj) { const f32x4 v0 = acc[ai][bj][m][0] * gt, v1 = acc[ai][bj][m][1] * gt;
                        v4u w; w.x = cvt_pk_bf16(v0[0], v0[1]); w.y = cvt_pk_bf16(v0[2], v0[3]); w.z = cvt_pk_bf16(v1[0], v1[1]); w.w = cvt_pk_bf16(v1[2], v1[3]);
                        *(v4u*)(yr + bj * 128) = w; } } }
    }
};
__device__ __forceinline__ void moe_tiles(const int* cnt, LAS int* tpre, int tid) {
    if (tid == 0) { int s = 0; for (int e = 0; e < NE; ++e) { tpre[e] = s; s += (cnt[e * 64] + 255) >> 8; } tpre[NE] = s; }
    __syncthreads();
}

struct S5Order {
    const bf16* A; const bf16* Bt; int K, lda;
    size_t gstrideB; int NP, G, c;
    __device__ __forceinline__ bool next(int i, pg8::Unit& u) const {
        const int L = i * G + c; if (L >= SG * NP) return false;
        u.e = L / NP; u.pn = L % NP; u.pm = 0; u.li = i; return true;
    }
    __device__ __forceinline__ const char* a_tile(const pg8::Unit& u) const { return (const char*)A + (size_t)u.e * 256 * S5LD * 2; }
    __device__ __forceinline__ const char* b_tile(const pg8::Unit& u) const { return (const char*)Bt + ((size_t)u.e * gstrideB + (size_t)u.pn * 256 * K) * 2; }
    __device__ __forceinline__ const LAS int* a_rows(const pg8::Unit&) const { return nullptr; }
    __device__ __forceinline__ void a_ready(const pg8::Unit&) const {}
};
struct EpiS5A {
    static constexpr bool PERM = false;
    float* xend;
    __device__ __forceinline__ void operator()(const f32x4 (&acc)[2][2][4][2], const pg8::Unit& u, int wr, int wc, int fr, int fq) const {
        const int row0 = wr * 64 + fr, col0 = wc * 32 + 4 * fq;
        float* base = xend + (size_t)u.e * 128 * 256;
#pragma unroll
        for (int ai = 0; ai < 2; ++ai)
#pragma unroll
            for (int m = 0; m < 4; ++m) { const int row = row0 + ai * 128 + m * 16;
#pragma unroll
                for (int n = 0; n < 2; ++n) { const f32x4 v = acc[ai][0][m][n];
#pragma unroll
                    for (int j = 0; j < 4; ++j) base[(size_t)(col0 + n * 16 + j) * 256 + row] = v[j]; } }
    }
};
struct EpiS5C {
    static constexpr bool PERM = true;
    bf16* zb;
    __device__ __forceinline__ void operator()(const f32x4 (&acc)[2][2][4][2], const pg8::Unit& u, int wr, int wc, int fr, int fq) const {
        const int row0 = wr * 64 + fr;
#pragma unroll
        for (int bj = 0; bj < 2; ++bj) { const int col = u.pn * 256 + bj * 128 + wc * 32 + 8 * fq, t = col >> 4, c = col & 15;
#pragma unroll
            for (int ai = 0; ai < 2; ++ai)
#pragma unroll
                for (int m = 0; m < 4; ++m) { const int row = row0 + ai * 128 + m * 16;
                    const f32x4 a = acc[ai][bj][m][0], b = acc[ai][bj][m][1];
                    float v[8] = {a[0], a[1], a[2], a[3], b[0], b[1], b[2], b[3]};
#pragma unroll
                    for (int j = 0; j < 8; ++j) { const float x = v[j], w = 0.7978845608028654f * (x + 0.044715f * x * x * x); v[j] = x * __builtin_amdgcn_rcpf(1.f + __builtin_amdgcn_exp2f(-2.8853900817779268f * w)); }
                    v4u w; w.x = cvt_pk_bf16(v[0], v[1]); w.y = cvt_pk_bf16(v[2], v[3]); w.z = cvt_pk_bf16(v[4], v[5]); w.w = cvt_pk_bf16(v[6], v[7]);
                    *(v4u*)(zb + ((size_t)row * 32 + t) * SW + u.e * 16 + c) = w; } }
    }
};
struct EpiGLU {
    static constexpr bool PERM = true;
    const bf16* zb; bf16* mixb;
    __device__ __forceinline__ void operator()(const f32x4 (&acc)[2][2][4][2], const pg8::Unit& u, int wr, int wc, int fr, int fq) const {
        const int row0 = u.pm * 256 + wr * 64 + fr;
#pragma unroll
        for (int bj = 0; bj < 2; ++bj) { const int col = u.pn * 256 + bj * 128 + wc * 32 + 8 * fq;
            if (col < SW) {
#pragma unroll
                for (int ai = 0; ai < 2; ++ai)
#pragma unroll
                    for (int m = 0; m < 4; ++m) { const int row = row0 + ai * 128 + m * 16;
                        const v4u zz = *(const v4u*)(zb + (size_t)row * SW + col);
                        const f32x4 a = acc[ai][bj][m][0], b = acc[ai][bj][m][1];
                        const float g[8] = {a[0], a[1], a[2], a[3], b[0], b[1], b[2], b[3]};
                        const unsigned zu[4] = {zz.x, zz.y, zz.z, zz.w};
                        float v[8];
#pragma unroll
                        for (int j = 0; j < 4; ++j) { v[2 * j] = __builtin_bit_cast(float, zu[j] << 16) * sigmoidf_(g[2 * j]); v[2 * j + 1] = __builtin_bit_cast(float, zu[j] & 0xffff0000u) * sigmoidf_(g[2 * j + 1]); }
                        v4u w; w.x = cvt_pk_bf16(v[0], v[1]); w.y = cvt_pk_bf16(v[2], v[3]); w.z = cvt_pk_bf16(v[4], v[5]); w.w = cvt_pk_bf16(v[6], v[7]);
                        *(v4u*)(mixb + (size_t)row * DM + AW + col) = w; } } }
    }
};
__device__ __forceinline__ void s5_tables(const Args& a, int ll, int g, LAS float* L, int tid) {
    LAS float* P = L; LAS float* Bb = L + 33 * 128; LAS float* Cc = Bb + 2048; LAS float* Kj = Cc + 2048;
    const float* a_re = a.in[8] + (size_t)(ll * SG + g) * SN; const float* a_im = a.in[9] + (size_t)(ll * SG + g) * SN;
    const float dt = expf(a.in[10][ll * SG + g]);
    const float* b_re = a.in[11] + (size_t)(ll * SG + g) * SN * SC; const float* b_im = a.in[12] + (size_t)(ll * SG + g) * SN * SC;
    const float* c_re = a.in[13] + (size_t)(ll * SG + g) * SC * SN; const float* c_im = a.in[14] + (size_t)(ll * SG + g) * SC * SN;
    const float* dsk = a.in[15] + ll * SW + g * SC;
    __syncthreads();
    for (int i = tid; i < 33 * 64; i += NTHR) { const int j = i >> 6, n = i & 63;
        const float lr = fminf(a_re[n], -1e-4f), li = a_im[n];
        const float mag = expf(lr * dt * (float)j), ang = li * dt * (float)j;
        P[i * 2] = mag * cosf(ang); P[i * 2 + 1] = mag * sinf(ang); }
    for (int i = tid; i < 64 * 16; i += NTHR) { const int n = i >> 4;
        const float lr = fminf(a_re[n], -1e-4f), li = a_im[n];
        const float mag = expf(lr * dt), abr = mag * cosf(li * dt), abi = mag * sinf(li * dt);
        const float den = lr * lr + li * li, nr = abr - 1.f, ni = abi;
        const float fre = (nr * lr + ni * li) / den, fim = (ni * lr - nr * li) / den;
        const float br = b_re[i], bi = b_im[i];
        Bb[i * 2] = fre * br - fim * bi; Bb[i * 2 + 1] = fre * bi + fim * br; }
    for (int i = tid; i < 16 * 64; i += NTHR) { Cc[i * 2] = c_re[i]; Cc[i * 2 + 1] = c_im[i]; }
    __syncthreads();
    if (tid < 64) { a.s5a32[((size_t)(ll * SG + g) * 64 + tid) * 2] = P[(32 * 64 + tid) * 2]; a.s5a32[((size_t)(ll * SG + g) * 64 + tid) * 2 + 1] = P[(32 * 64 + tid) * 2 + 1]; }
    for (int i = tid; i < 32 * 256; i += NTHR) { const int j = i >> 8, c = (i >> 4) & 15, cp = i & 15; float s = 0.f;
        for (int n = 0; n < 64; ++n) { const float cr = Cc[(c * 64 + n) * 2], ci = Cc[(c * 64 + n) * 2 + 1], pr = P[(j * 64 + n) * 2], pi = P[(j * 64 + n) * 2 + 1];
            const float wr_ = cr * pr - ci * pi, wi_ = cr * pi + ci * pr; s += wr_ * Bb[(n * 16 + cp) * 2] - wi_ * Bb[(n * 16 + cp) * 2 + 1]; }
        if (j == 0 && c == cp) s += dsk[c];
        Kj[i] = s; }
    __syncthreads();
    bf16* et = a.s5et + (size_t)(ll * SG + g) * 256 * 512;
    for (int i = tid; i < 256 * 64; i += NTHR) { const int row = i >> 6, c8 = (i & 63) * 8; unsigned w[4] = {0u, 0u, 0u, 0u};
        if (row < 128) { const int part = row >> 6, n = row & 63, sidx = c8 >> 4, c0 = c8 & 15; float v[8];
            const float pr = P[((31 - sidx) * 64 + n) * 2], pi = P[((31 - sidx) * 64 + n) * 2 + 1];
#pragma unroll
            for (int j = 0; j < 8; ++j) { const float br = Bb[(n * 16 + c0 + j) * 2], bi = Bb[(n * 16 + c0 + j) * 2 + 1]; v[j] = part ? (pr * bi + pi * br) : (pr * br - pi * bi); }
#pragma unroll
            for (int j = 0; j < 4; ++j) w[j] = pk2(v[2 * j], v[2 * j + 1]); }
        *(v4u*)(et + (size_t)row * 512 + c8) = (v4u){w[0], w[1], w[2], w[3]}; }
    bf16* mf = a.s5mf + (size_t)(ll * SG + g) * 512 * 640;
    for (int i = tid; i < 512 * 80; i += NTHR) { const int row = i / 80, c8 = (i % 80) * 8, t = row >> 4, c = row & 15; float v[8];
        if (c8 < 512) { const int sidx = c8 >> 4, c0 = c8 & 15;
#pragma unroll
            for (int j = 0; j < 8; ++j) v[j] = sidx <= t ? Kj[((t - sidx) * 16 + c) * 16 + c0 + j] : 0.f;
        } else { const int part = (c8 - 512) >> 6, n0 = (c8 - 512) & 63;
#pragma unroll
            for (int j = 0; j < 8; ++j) { const int n = n0 + j; const float cr = Cc[(c * 64 + n) * 2], ci = Cc[(c * 64 + n) * 2 + 1], pr = P[((t + 1) * 64 + n) * 2], pi = P[((t + 1) * 64 + n) * 2 + 1];
                v[j] = part ? -(cr * pi + ci * pr) : (cr * pr - ci * pi); } }
        *(v4u*)(mf + (size_t)row * 640 + c8) = (v4u){pk2(v[0], v[1]), pk2(v[2], v[3]), pk2(v[4], v[5]), pk2(v[6], v[7])}; }
    __syncthreads();
}
__device__ __forceinline__ void s5_scan_unit(const Args& a, int l, int b, int g, LAS float* L, int tid) {
    LAS float* X = L;
    __syncthreads();
    const float* src = a.xend + (size_t)g * 128 * 256 + b * 128;
    for (int i = tid; i < 128 * 128; i += NTHR) { const int p = i >> 7, k = i & 127; X[p * 129 + k] = src[(size_t)p * 256 + k]; }
    __syncthreads();
    if (tid < 64) { const int n = tid; const float ar = a.s5a32[((size_t)(l * SG + g) * 64 + n) * 2], ai = a.s5a32[((size_t)(l * SG + g) * 64 + n) * 2 + 1];
        float xr = 0.f, xi = 0.f;
#pragma unroll 16
        for (int k = 0; k < 128; ++k) { const float er = X[n * 129 + k], ei = X[(64 + n) * 129 + k];
            X[n * 129 + k] = xr; X[(64 + n) * 129 + k] = xi;
            const float nr = ar * xr - ai * xi + er, ni = ar * xi + ai * xr + ei; xr = nr; xi = ni; } }
    __syncthreads();
    bf16* dst = a.ug + ((size_t)g * 256 + b * 128) * S5LD + 512;
    for (int i = tid; i < 128 * 64; i += NTHR) { const int k = i >> 6, p2 = (i & 63) * 2;
        *(unsigned*)(dst + (size_t)k * S5LD + p2) = pk2(X[p2 * 129 + k], X[(p2 + 1) * 129 + k]); }
}

namespace hg {
typedef short s16x4 __attribute__((ext_vector_type(4)));
typedef float f32x16 __attribute__((ext_vector_type(16)));
typedef unsigned u32x4 __attribute__((ext_vector_type(4)));
constexpr int CH = 64, NCH = SEQ / CH, NUN = BATCH * HH * NCH;
#define HKSWZ(row, colB) ((row) * 256 + ((colB) ^ (((row) & 7) << 4)))
template <bool SWAP> __device__ __forceinline__ int vst(int k, int c) { const int kk = SWAP ? ((k & ~0xC) | ((k & 4) << 1) | ((k & 8) >> 1)) : k; return ((kk >> 3) * 4 + (c >> 5)) * 512 + ((kk & 7) * 32 + (c & 31)) * 2; }
__device__ __forceinline__ int v_rd_base(int lane) { return ((lane & 3) << 3) | (((lane >> 2) & 3) << 6) | (((lane >> 4) & 1) << 5) | (((lane >> 5) & 1) << 8); }
#define HTRRD(dst, off) asm volatile("ds_read_b64_tr_b16 %0, %1 offset:%2" : "=&v"(dst) : "v"(vb0), "i"(off) : "memory")
#define HFRAG(out, TOFF, cb, ks) do { s16x4 l_, h_; HTRRD(l_, (TOFF) + (cb) * 512 + (ks) * 4096); HTRRD(h_, (TOFF) + (cb) * 512 + (ks) * 4096 + 2048); \
        asm volatile("s_waitcnt lgkmcnt(0)" ::: "memory"); __builtin_amdgcn_sched_barrier(0); out = (bf16x8){l_[0], l_[1], l_[2], l_[3], h_[0], h_[1], h_[2], h_[3]}; } while (0)
__device__ __forceinline__ void unit_decode(int u, int& b, int& h, int& c) { c = u % NCH; const int bh = u / NCH; b = bh / HH; h = bh % HH; }

struct Cum { float gl[16]; float off, g31, g63; };
__device__ __forceinline__ void cum_logf(const float* __restrict__ lf, size_t tok0, int colb, int d, int seg, LAS float* st, Cum& C) {
    float s = 0.f;
#pragma unroll
    for (int i = 0; i < 16; ++i) { s += lf[(tok0 + seg * 16 + i) * HW + colb + d]; C.gl[i] = s; }
    st[seg * 128 + d] = s;
    __syncthreads();
    const float s0 = st[d], s1 = st[128 + d], s2 = st[256 + d], s3 = st[384 + d];
    C.off = seg == 0 ? 0.f : (seg == 1 ? s0 : (seg == 2 ? s0 + s1 : s0 + s1 + s2));
    C.g31 = s0 + s1; C.g63 = (s0 + s1) + (s2 + s3);
}
__device__ __forceinline__ int cum_logf_q(const float* __restrict__ lf, size_t tok0, int colb, int d, int seg, LAS float* st, Cum& C, bool fetch, unsigned* hq, volatile LAS int* nu, int tid) {
    float lv[16];
#pragma unroll
    for (int i = 0; i < 16; ++i) lv[i] = lf[(tok0 + seg * 16 + i) * HW + colb + d];
    int nr = NUN;
    if (fetch && tid == 0) nr = (int)atomicAdd(hq, 1u);
    float s = 0.f;
#pragma unroll
    for (int i = 0; i < 16; ++i) { s += lv[i]; C.gl[i] = s; }
    st[seg * 128 + d] = s;
    if (tid == 0) nu[1] = nr;
    __syncthreads();
    const float s0 = st[d], s1 = st[128 + d], s2 = st[256 + d], s3 = st[384 + d];
    C.off = seg == 0 ? 0.f : (seg == 1 ? s0 : (seg == 2 ? s0 + s1 : s0 + s1 + s2));
    C.g31 = s0 + s1; C.g63 = (s0 + s1) + (s2 + s3);
    return nu[1];
}
#define HG_PF(dst, ptr) asm volatile("global_load_dword %0, %1, off" : "=v"(dst) : "v"(ptr) : "memory")
__device__ __forceinline__ int hg1_unit(const Args& a, int u, char* lds, int tid, bool fetch, unsigned* hq, volatile LAS int* nu, unsigned& pf0) {
    const int lane = tid & 63, wid = __builtin_amdgcn_readfirstlane(tid >> 6), r32 = lane & 31, hi = lane >> 5;
    int b, h, c; unit_decode(u, b, h, c);
    const size_t tok0 = (size_t)b * SEQ + (size_t)c * CH; const int colb = h * HD;
    LAS float* st = (LAS float*)((LAS char*)lds + MISC_OFF);
    const int d = tid & 127, seg = tid >> 7;
    __syncthreads();
    { const int sr = tid >> 4, sc = (tid & 15) * 8;
        const bf16x8 v0 = *(const bf16x8*)(a.hv + (tok0 + sr) * HW + colb + sc), v1 = *(const bf16x8*)(a.hv + (tok0 + 32 + sr) * HW + colb + sc);
        *(bf16x8*)(lds + 16384 + vst<true>(sr, sc)) = v0; *(bf16x8*)(lds + 16384 + vst<true>(32 + sr, sc)) = v1; }
    bf16 kraw[16];
#pragma unroll
    for (int i = 0; i < 16; ++i) kraw[i] = a.hk[(tok0 + seg * 16 + i) * HW + colb + d];
    Cum C; const int un = cum_logf_q(a.hlogf, tok0, colb, d, seg, st, C, fetch, hq, nu, tid);
    asm volatile("" :: "v"(pf0));
    if (un < NUN) { int nb, nh, nc; unit_decode(un, nb, nh, nc); const size_t tokn = (size_t)nb * SEQ + (size_t)nc * CH; const int coln = nh * HD;
        const int j0 = tid & 127, j1 = tid - 256;
        const void* p0 = tid < 256 ? (const void*)(a.hq + (size_t)(1 + (tid >> 7)) * ((size_t)T * HW) + (tokn + (j0 >> 1)) * HW + coln + (j0 & 1) * 64)
                                   : (const void*)(a.hlogf + (tokn + (j1 >> 2)) * HW + coln + (j1 & 3) * 32);
        HG_PF(pf0, p0); }
#pragma unroll
    for (int i = 0; i < 16; ++i) { const int t = seg * 16 + i; const float kv = bf2f(kraw[i]);
        *(bf16*)(lds + vst<true>(t, d)) = (bf16)pk2(kv * __expf(C.g63 - (C.off + C.gl[i])), 0.f); }
    if (seg == 0) a.hdb[(size_t)u * HD + d] = __expf(C.g63);
    __syncthreads();
    const int vb0 = (int)(uintptr_t)lds + v_rd_base(lane);
    const int db = wid & 3, vp = wid >> 2;
    f32x16 acc0 = {}, acc1 = {};
#pragma unroll
    for (int ks = 0; ks < 4; ++ks) { bf16x8 fa, fb0, fb1;
        if (db == 0) HFRAG(fa, 0, 0, ks); else if (db == 1) HFRAG(fa, 0, 1, ks); else if (db == 2) HFRAG(fa, 0, 2, ks); else HFRAG(fa, 0, 3, ks);
        if (vp == 0) { HFRAG(fb0, 16384, 0, ks); HFRAG(fb1, 16384, 1, ks); } else { HFRAG(fb0, 16384, 2, ks); HFRAG(fb1, 16384, 3, ks); }
        acc0 = __builtin_amdgcn_mfma_f32_32x32x16_bf16(fa, fb0, acc0, 0, 0, 0);
        acc1 = __builtin_amdgcn_mfma_f32_32x32x16_bf16(fa, fb1, acc1, 0, 0, 0); }
    bf16* ub = a.hub + (size_t)u * HD * HD + (size_t)(db * 32 + 4 * hi) * HD + vp * 64 + r32;
#pragma unroll
    for (int r = 0; r < 16; ++r) { const int cr = (r & 3) + 8 * (r >> 2);
        const float x0 = acc0[r], x1 = acc1[r]; const float n0 = nbr1(x0), n1 = nbr1(x1);
        if ((r32 & 1) == 0) { *(unsigned*)(ub + (size_t)cr * HD) = cvt_pk_bf16(x0, n0); *(unsigned*)(ub + (size_t)cr * HD + 32) = cvt_pk_bf16(x1, n1); } }
    return un;
}
__device__ __forceinline__ void hg2(const Args& a, int gtid, int gthreads) {
    for (int id = gtid; id < BATCH * HH * HD * (HD / 4); id += gthreads) {
        const int bh = id / (HD * (HD / 4)), rem = id % (HD * (HD / 4)), d = rem >> 5, v4 = (rem & 31) * 4;
        float S0 = 0.f, S1 = 0.f, S2 = 0.f, S3 = 0.f;
        v2u ua[8], ub[8]; float da[8], db[8];
#define HG2_LD(U_, D_, c0_) do { _Pragma("unroll") for (int j = 0; j < 8; ++j) { const size_t un = (size_t)bh * NCH + (c0_) + j; U_[j] = *(const v2u*)(a.hub + un * HD * HD + (size_t)d * HD + v4); D_[j] = a.hdb[un * HD + d]; } } while (0)
#define HG2_RUN(U_, D_, c0_) do { _Pragma("unroll") for (int j = 0; j < 8; ++j) { const size_t un = (size_t)bh * NCH + (c0_) + j;                \
                v2u w; w.x = cvt_pk_bf16(S0, S1); w.y = cvt_pk_bf16(S2, S3); *(v2u*)(a.hsp + un * HD * HD + (size_t)d * HD + v4) = w;                        \
                S0 = D_[j] * S0 + __builtin_bit_cast(float, U_[j].x << 16); S1 = D_[j] * S1 + __builtin_bit_cast(float, U_[j].x & 0xffff0000u);              \
                S2 = D_[j] * S2 + __builtin_bit_cast(float, U_[j].y << 16); S3 = D_[j] * S3 + __builtin_bit_cast(float, U_[j].y & 0xffff0000u); } } while (0)
        HG2_LD(ua, da, 0);
        for (int c0 = 0; c0 < NCH; c0 += 16) {
            HG2_LD(ub, db, c0 + 8);
            HG2_RUN(ua, da, c0);
            if (c0 + 16 < NCH) HG2_LD(ua, da, c0 + 16);
            HG2_RUN(ub, db, c0 + 8);
        }
#undef HG2_LD
#undef HG2_RUN
    }
}
__device__ __forceinline__ int hg3_unit(const Args& a, int l, int u, char* lds, int tid, unsigned* hq, volatile LAS int* nu, unsigned& pf0, unsigned& pf1) {
    const int lane = tid & 63, wid = __builtin_amdgcn_readfirstlane(tid >> 6), r32 = lane & 31, hi = lane >> 5;
    int b, h, c; unit_decode(u, b, h, c);
    const size_t tok0 = (size_t)b * SEQ + (size_t)c * CH; const int colb = h * HD;
    LAS float* st = (LAS float*)((LAS char*)lds + MISC_OFF); LAS float* ps = (LAS float*)((LAS char*)lds + MISC_OFF + 2048);
    const int d = tid & 127, seg = tid >> 7;
    __syncthreads();
    { const int sr = tid >> 4, sc = (tid & 15) * 8;
        const bf16x8 v0 = *(const bf16x8*)(a.hv + (tok0 + sr) * HW + colb + sc), v1 = *(const bf16x8*)(a.hv + (tok0 + 32 + sr) * HW + colb + sc);
        *(bf16x8*)(lds + vst<true>(sr, sc)) = v0; *(bf16x8*)(lds + vst<true>(32 + sr, sc)) = v1;
        const bf16* sp = a.hsp + (size_t)u * HD * HD;
#pragma unroll
        for (int i = 0; i < 4; ++i) { const int dr = sr + 32 * i; const bf16x8 x = *(const bf16x8*)(sp + (size_t)dr * HD + sc);
            *(bf16x8*)(lds + 16384 + (dr >> 6) * 16384 + vst<false>(dr & 63, sc)) = x; } }
    bf16 qraw[16], kraw[16];
#pragma unroll
    for (int i = 0; i < 16; ++i) { qraw[i] = a.hq[(tok0 + seg * 16 + i) * HW + colb + d]; kraw[i] = a.hk[(tok0 + seg * 16 + i) * HW + colb + d]; }
    const int rgp = wid >> 2, vb = wid & 3;
    int hi4g = 4 * hi; asm volatile("" : "+v"(hi4g));
    const bf16* gp = a.hg + (tok0 + rgp * 32 + hi4g) * HW + colb + vb * 32 + r32;
    bf16 graw[16];
#pragma unroll
    for (int r = 0; r < 16; ++r) graw[r] = gp[(size_t)((r & 3) + 8 * (r >> 2)) * HW];
    const float gn = a.in[18][l * HD + vb * 32 + r32];
    Cum C; const int un = cum_logf_q(a.hlogf, tok0, colb, d, seg, st, C, true, hq, nu, tid);
    asm volatile("" :: "v"(pf0), "v"(pf1));
    if (un < NUN) { int nb, nh, nc; unit_decode(un, nb, nh, nc); const size_t tokn = (size_t)nb * SEQ + (size_t)nc * CH; const int coln = nh * HD;
        const int j0 = tid & 127;
        const bf16* p0 = a.hq + (size_t)(tid >> 7) * ((size_t)T * HW) + (tokn + (j0 >> 1)) * HW + coln + (j0 & 1) * 64;
        const void* p1 = tid < 256 ? (const void*)(a.hlogf + (tokn + (tid >> 2)) * HW + coln + (tid & 3) * 32) : (const void*)(a.hsp + (size_t)un * HD * HD + (size_t)(tid - 256) * 64);
        HG_PF(pf0, p0); HG_PF(pf1, p1); }
    const float bref = seg >= 2 ? C.g31 : 0.f;
#pragma unroll
    for (int i = 0; i < 16; ++i) { const int t = seg * 16 + i; const float G = C.off + C.gl[i];
        const float qv = bf2f(qraw[i]), kv = bf2f(kraw[i]);
        const int o = HKSWZ(t, d * 2);
        *(bf16*)(lds + 49152 + o) = (bf16)pk2(qv * __expf(G), 0.f);
        *(bf16*)(lds + 65536 + o) = (bf16)pk2(qv * __expf(G - bref), 0.f);
        *(bf16*)(lds + 81920 + o) = (bf16)pk2(kv * __expf(bref - G), 0.f);
        if (seg < 2) *(bf16*)(lds + 98304 + o) = (bf16)pk2(kv * __expf(C.g31 - G), 0.f); }
    __syncthreads();
    const int vb0 = (int)(uintptr_t)lds + v_rd_base(lane);
    f32x16 o = {};
#pragma unroll
    for (int ks = 0; ks < 8; ++ks) { const bf16x8 fa = *(const bf16x8*)(lds + 49152 + HKSWZ(rgp * 32 + r32, (ks * 16 + hi * 8) * 2)); bf16x8 fb;
        const int T0 = 16384 + (ks >> 2) * 16384;
        if (vb == 0) HFRAG(fb, T0, 0, ks & 3); else if (vb == 1) HFRAG(fb, T0, 1, ks & 3); else if (vb == 2) HFRAG(fb, T0, 2, ks & 3); else HFRAG(fb, T0, 3, ks & 3);
        o = __builtin_amdgcn_mfma_f32_32x32x16_bf16(fa, fb, o, 0, 0, 0); }
#define HPK4(P, B_, OUT) do { unsigned a0 = cvt_pk_bf16(P[B_+0], P[B_+1]), a1 = cvt_pk_bf16(P[B_+2], P[B_+3]);                          \
        unsigned b0 = cvt_pk_bf16(P[B_+4], P[B_+5]), b1 = cvt_pk_bf16(P[B_+6], P[B_+7]);                                             \
        auto r0 = __builtin_amdgcn_permlane32_swap(a0, b0, false, false); auto r1 = __builtin_amdgcn_permlane32_swap(a1, b1, false, false); \
        u32x4 w = {r0[0], r1[0], r0[1], r1[1]}; OUT = *reinterpret_cast<bf16x8*>(&w); } while (0)
#define HPV(pa, ksv) do { bf16x8 fb; if (vb == 0) HFRAG(fb, 0, 0, ksv); else if (vb == 1) HFRAG(fb, 0, 1, ksv); else if (vb == 2) HFRAG(fb, 0, 2, ksv); else HFRAG(fb, 0, 3, ksv); \
        o = __builtin_amdgcn_mfma_f32_32x32x16_bf16(pa, fb, o, 0, 0, 0); } while (0)
    { f32x16 p = {};
#pragma unroll
        for (int ks = 0; ks < 8; ++ks) { const int co = HKSWZ(rgp * 32 + r32, (ks * 16 + hi * 8) * 2);
            p = __builtin_amdgcn_mfma_f32_32x32x16_bf16(*(const bf16x8*)(lds + 81920 + co), *(const bf16x8*)(lds + 65536 + co), p, 0, 0, 0); }
#pragma unroll
        for (int r = 0; r < 16; ++r) { const int cr = (r & 3) + 8 * (r >> 2) + 4 * hi; if (cr > r32) p[r] = 0.f; }
        bf16x8 pa0, pa1; HPK4(p, 0, pa0); HPK4(p, 8, pa1);
        if (rgp == 0) { HPV(pa0, 0); HPV(pa1, 1); } else { HPV(pa0, 2); HPV(pa1, 3); } }
    if (rgp == 1) { f32x16 p = {};
#pragma unroll
        for (int ks = 0; ks < 8; ++ks) { const int cb = (ks * 16 + hi * 8) * 2;
            p = __builtin_amdgcn_mfma_f32_32x32x16_bf16(*(const bf16x8*)(lds + 98304 + HKSWZ(r32, cb)), *(const bf16x8*)(lds + 65536 + HKSWZ(32 + r32, cb)), p, 0, 0, 0); }
#pragma unroll
        for (int r = 0; r < 16; ++r) p[r] = fmaxf(p[r], -3.0e38f);
        bf16x8 pa0, pa1; HPK4(p, 0, pa0); HPK4(p, 8, pa1);
        HPV(pa0, 0); HPV(pa1, 1); }
#undef HPK4
#undef HPV
    int hi4 = 4 * hi; asm volatile("" : "+v"(hi4));
#pragma unroll
    for (int r = 0; r < 16; ++r) { const int cr = (r & 3) + 8 * (r >> 2); float ss = o[r] * o[r];
        ss = sum32(ss);
        if (r32 == 0) ps[(rgp * 32 + hi4 + cr) * 4 + vb] = ss; }
    __syncthreads();
    bf16* op = a.mixb + (tok0 + rgp * 32 + hi4) * DM + AW + SW + colb + vb * 32 + r32;
#pragma unroll
    for (int r = 0; r < 16; ++r) { const int cr = (r & 3) + 8 * (r >> 2);
        const f32x4 q = *(const LAS f32x4*)(ps + (rgp * 32 + hi4 + cr) * 4);
        const float rs = __builtin_amdgcn_rsqf(((q[0] + q[1]) + (q[2] + q[3])) * (1.f / 128.f) + EPS);
        const float v = o[r] * rs * gn * bf2f(graw[r]); const float vn = nbr1(v);
        if ((r32 & 1) == 0) *(unsigned*)(op + (size_t)cr * DM) = cvt_pk_bf16(v, vn); }
    return un;
}
#undef HKSWZ
#undef HTRRD
#undef HFRAG
#undef HG_PF
}

namespace att {
typedef short s16x4 __attribute__((ext_vector_type(4)));
typedef float f32x16 __attribute__((ext_vector_type(16)));
typedef unsigned u32x4 __attribute__((ext_vector_type(4)));
constexpr int QB = 128, KVBLK = 64, SHM_V = KVBLK * 128 * 2, SHM_K = KVBLK * 128 * 2;
constexpr int OFF_V = 0, OFF_K = 2 * SHM_V, OFF_X = 65536;
constexpr int OFF_WS = MISC_OFF, OFF_TAB = MISC_OFF + 8192, OFF_C = MISC_OFF + 8192 + AH * 128 * 4;
constexpr int NUNITS = BATCH * AH * (SEQ / QB);
constexpr float SCALE = 0.125f, THR = 8.f;
#define KSWZ(row, colB) ((row) * 256 + ((colB) ^ (((row) & 7) << 4)))
#define SBAR() __builtin_amdgcn_sched_barrier(0)
__device__ __forceinline__ int v_st(int k, int c) { const int kk = (k & ~0xC) | ((k & 4) << 1) | ((k & 8) >> 1); return ((kk >> 3) * 4 + (c >> 5)) * 512 + ((kk & 7) * 32 + (c & 31)) * 2; }
__device__ __forceinline__ int v_rd_base(int lane) { return ((lane & 3) << 3) | (((lane >> 2) & 3) << 6) | (((lane >> 4) & 1) << 5) | (((lane >> 5) & 1) << 8); }
constexpr int v_rd_off(int d0, int ks, int half) { return d0 * 512 + ks * 4096 + half * 2048; }
__device__ __forceinline__ int crow(int r, int hi) { return (r & 3) + 8 * (r >> 2) + 4 * hi; }
__device__ __forceinline__ bf16x8 ld8(const bf16* p) { return *reinterpret_cast<const bf16x8*>(p); }

__device__ __forceinline__ void mask_tile(f32x16& p0, f32x16& p1, int dq) {
    const float NEG = -__builtin_inff();
#pragma unroll
    for (int r = 0; r < 16; ++r) { const int c = (r & 3) + 8 * (r >> 2);
        if (dq - c < 0) p0[r] = NEG;
        if (dq - c - 32 < 0) p1[r] = NEG; }
}
__device__ __forceinline__ void bias_tile(f32x16& p0, f32x16& p1, int dq, const LAS float* tab) {
#pragma unroll
    for (int r = 0; r < 16; ++r) { const int c = (r & 3) + 8 * (r >> 2);
        int d0 = dq - c, d1 = dq - c - 32;
        d0 = d0 < 0 ? 0 : (d0 > 127 ? 127 : d0); d1 = d1 < 0 ? 0 : (d1 > 127 ? 127 : d1);
        p0[r] += tab[d0]; p1[r] += tab[d1]; }
}
__device__ __forceinline__ void partialSM(f32x16& p0, f32x16& p1, float& m_reg, float& mn, float& alpha) {
    float pmax = p0[0];
#pragma unroll
    for (int r = 1; r < 16; ++r) pmax = fmaxf(pmax, p0[r]);
#pragma unroll
    for (int r = 0; r < 16; ++r) pmax = fmaxf(pmax, p1[r]);
    { auto rr = __builtin_amdgcn_permlane32_swap(__float_as_uint(pmax), __float_as_uint(pmax), false, false);
      pmax = fmaxf(__uint_as_float(rr[0]), __uint_as_float(rr[1])); }
    constexpr float C2 = 1.4426950408889634f * SCALE;
    if (__builtin_expect(__all((pmax - m_reg) * SCALE <= THR), 1)) { mn = m_reg; alpha = 1.f; }
    else { mn = fmaxf(m_reg, pmax); alpha = __builtin_amdgcn_exp2f((m_reg - mn) * C2); m_reg = mn; }
    const float mnL = -mn * C2;
#pragma unroll
    for (int r = 0; r < 16; ++r) p0[r] = fmaf(p0[r], C2, mnL);
#pragma unroll
    for (int r = 0; r < 16; ++r) p1[r] = fmaf(p1[r], C2, mnL);
#pragma unroll
    for (int r = 0; r < 16; ++r) p0[r] = __builtin_amdgcn_exp2f(p0[r]);
}
__device__ __forceinline__ void finishSM(f32x16& p0, f32x16& p1, float alpha, float& l_reg, bf16x8& pa0, bf16x8& pa1, bf16x8& pa2, bf16x8& pa3) {
#pragma unroll
    for (int r = 0; r < 16; ++r) p1[r] = __builtin_amdgcn_exp2f(p1[r]);
    float ps = 0;
#pragma unroll
    for (int r = 0; r < 16; ++r) ps += p0[r];
#pragma unroll
    for (int r = 0; r < 16; ++r) ps += p1[r];
    { auto rr = __builtin_amdgcn_permlane32_swap(__float_as_uint(ps), __float_as_uint(ps), false, false);
      ps = __uint_as_float(rr[0]) + __uint_as_float(rr[1]); }
    l_reg = l_reg * alpha + ps;
#define PK4(P, B_, OUT) do { unsigned a0 = cvt_pk_bf16(P[B_+0], P[B_+1]), a1 = cvt_pk_bf16(P[B_+2], P[B_+3]);                          \
        unsigned b0 = cvt_pk_bf16(P[B_+4], P[B_+5]), b1 = cvt_pk_bf16(P[B_+6], P[B_+7]);                                             \
        auto r0 = __builtin_amdgcn_permlane32_swap(a0, b0, false, false); auto r1 = __builtin_amdgcn_permlane32_swap(a1, b1, false, false); \
        u32x4 w = {r0[0], r1[0], r0[1], r1[1]}; OUT = *reinterpret_cast<bf16x8*>(&w); } while (0)
    PK4(p0, 0, pa0); PK4(p0, 8, pa1); PK4(p1, 0, pa2); PK4(p1, 8, pa3);
#undef PK4
}
template <int KB>
__device__ __forceinline__ void qkt(f32x16& p0, f32x16& p1, const char* K_lds, int r32, int hi, int map, const bf16x8* qr) {
    p0 = f32x16{}; p1 = f32x16{};
#pragma unroll
    for (int dd = 0; dd < 4; ++dd) { const char* a = K_lds + KB * SHM_K + KSWZ(r32, (dd * 16 + hi * 8) * 2) + map * 128;
        bf16x8 b0 = *reinterpret_cast<const bf16x8*>(a);
        bf16x8 b1 = *reinterpret_cast<const bf16x8*>(a + 32 * 256);
        p0 = __builtin_amdgcn_mfma_f32_32x32x16_bf16(b0, qr[dd], p0, 0, 0, 0);
        p1 = __builtin_amdgcn_mfma_f32_32x32x16_bf16(b1, qr[dd], p1, 0, 0, 0); }
}
template <int VB>
__device__ __forceinline__ void pv_tile(f32x16* o, int vb0, bf16x8 pa0, bf16x8 pa1, bf16x8 pa2, bf16x8 pa3) {
#define TRRD(dst, off) asm volatile("ds_read_b64_tr_b16 %0, %1 offset:%2" : "=&v"(dst) : "v"(vb0), "i"(off) : "memory")
#define PV_D0(d0) do { s16x4 l0, l1, l2, l3, h0, h1, h2, h3; constexpr int b_ = OFF_V + VB * SHM_V + v_rd_off(d0, 0, 0); \
        TRRD(l0, b_); TRRD(h0, b_ + 2048); TRRD(l1, b_ + 4096); TRRD(h1, b_ + 6144); TRRD(l2, b_ + 8192); TRRD(h2, b_ + 10240); TRRD(l3, b_ + 12288); TRRD(h3, b_ + 14336); \
        asm volatile("s_waitcnt lgkmcnt(0)" ::: "memory"); SBAR();   \
        o[d0] = __builtin_amdgcn_mfma_f32_32x32x16_bf16(pa0, (bf16x8){l0[0], l0[1], l0[2], l0[3], h0[0], h0[1], h0[2], h0[3]}, o[d0], 0, 0, 0);   \
        o[d0] = __builtin_amdgcn_mfma_f32_32x32x16_bf16(pa1, (bf16x8){l1[0], l1[1], l1[2], l1[3], h1[0], h1[1], h1[2], h1[3]}, o[d0], 0, 0, 0);   \
        o[d0] = __builtin_amdgcn_mfma_f32_32x32x16_bf16(pa2, (bf16x8){l2[0], l2[1], l2[2], l2[3], h2[0], h2[1], h2[2], h2[3]}, o[d0], 0, 0, 0);   \
        o[d0] = __builtin_amdgcn_mfma_f32_32x32x16_bf16(pa3, (bf16x8){l3[0], l3[1], l3[2], l3[3], h3[0], h3[1], h3[2], h3[3]}, o[d0], 0, 0, 0); } while (0)
    PV_D0(0); PV_D0(1); PV_D0(2); PV_D0(3);
#undef PV_D0
#undef TRRD
}
struct Ref { const bf16* Q; const bf16* K; const bf16* V; bf16* O; int P0; int h; };
struct Seam { bf16x8 qr[4]; bf16x8 st_v0, st_v1, st_k0, st_k1; };
__device__ __forceinline__ Ref make_ref(int L, const bf16* qb, const bf16* kb, const bf16* vb, bf16* mixb) {
    const int qblk = (SEQ / QB - 1) - L / (BATCH * AH), bh = L % (BATCH * AH), b = bh / AH, h = bh % AH;
    Ref r; const size_t t0 = (size_t)b * SEQ;
    r.Q = qb + (t0 + (size_t)qblk * QB) * AW + h * 128; r.K = kb + t0 * AW + h * 128; r.V = vb + t0 * AW + h * 128;
    r.O = mixb + (t0 + (size_t)qblk * QB) * DM + h * 128; r.P0 = qblk * QB; r.h = h; return r;
}
#define ROW(p, k0, rr) ((p) + (size_t)((k0) + (rr)) * AW + sc)
#define VMW() asm volatile("s_waitcnt vmcnt(0)" ::: "memory")
#define VMWN(n) asm volatile("s_waitcnt vmcnt(%0)" :: "i"(n) : "memory")
#define SLOAD_H(Kp, Vp, k0) do { S.st_v0 = ld8(ROW(Vp, k0, sr)); S.st_v1 = ld8(ROW(Vp, k0, 32 + sr)); S.st_k0 = ld8(ROW(Kp, k0, sr)); S.st_k1 = ld8(ROW(Kp, k0, 32 + sr)); } while (0)
#define SLOAD_K(Kp, k0) do { S.st_k0 = ld8(ROW(Kp, k0, sr)); S.st_k1 = ld8(ROW(Kp, k0, 32 + sr)); } while (0)
#define SLOAD_V(Vp, k0) do { S.st_v0 = ld8(ROW(Vp, k0, sr)); S.st_v1 = ld8(ROW(Vp, k0, 32 + sr)); } while (0)
#define SWRITE_HK(bf) do { *(bf16x8*)(K_lds + (bf) * SHM_K + kws) = S.st_k0; *(bf16x8*)(K_lds + (bf) * SHM_K + kws + 32 * 256) = S.st_k1; } while (0)
#define SWRITE_HV(bf) do { *(bf16x8*)(V_lds + (bf) * SHM_V + vst0) = S.st_v0; *(bf16x8*)(V_lds + (bf) * SHM_V + vst1) = S.st_v1; } while (0)
#define SWRITE_H(bf) do { SWRITE_HV(bf); SWRITE_HK(bf); } while (0)
__device__ __forceinline__ void prime(const Ref& cur, char* lds, Seam& S) {
    const int tid = tidx(), wid = __builtin_amdgcn_readfirstlane(tid >> 6), lane = tid & 63, r32 = lane & 31, hi = lane >> 5, rg = wid & 3, map = wid >> 2;
    const int sr = tid >> 4, sc = (tid & 15) * 8, kws = KSWZ(sr, sc * 2); char* K_lds = lds + OFF_K;
#pragma unroll
    for (int dd = 0; dd < 4; ++dd) S.qr[dd] = ld8(cur.Q + (size_t)(rg * 32 + r32) * AW + map * 64 + dd * 16 + hi * 8);
    SLOAD_H(cur.K, cur.V, 0); VMW(); SWRITE_HK(0);
    __syncthreads();
}
__device__ __forceinline__ void block(const Ref& cur, const Ref& nxt, char* lds, Seam& S, const float lam, const float osc, const float* __restrict__ subg) {
    const int tid = tidx(), wid = __builtin_amdgcn_readfirstlane(tid >> 6), lane = tid & 63, r32 = lane & 31, hi = lane >> 5, rg = wid & 3, map = wid >> 2;
    const int NT = cur.P0 / KVBLK + 2;
    const int qlo = cur.P0 + rg * 32, qm = qlo + r32 - 4 * hi;
    char* V_lds = lds + OFF_V; char* K_lds = lds + OFF_K;
    LAS float* wsf = (LAS float*)((LAS char*)lds + OFF_WS) + wid * 64; LAS float* li_l = wsf; LAS float* al_l = wsf + 32;
    const LAS float* tab = (const LAS float*)((LAS char*)lds + OFF_TAB) + cur.h * 128;
    float m_reg = -1e30f, l_reg = 0; f32x16 o[4] = {};
    const int sr = tid >> 4, sc = (tid & 15) * 8, vst0 = v_st(sr, sc), vst1 = v_st(32 + sr, sc), kws = KSWZ(sr, sc * 2);
    const int vb0 = (int)(uintptr_t)lds + v_rd_base(lane);
    const bf16* Kh = cur.K; const bf16* Vh = cur.V;
#define RESC(a) do { if (__any((a) < 1.f)) { if (hi == 0) al_l[r32] = (a); asm volatile("s_waitcnt lgkmcnt(0)" ::: "memory");              \
                     for (int d_ = 0; d_ < 4; ++d_) for (int r = 0; r < 16; ++r) o[d_][r] *= al_l[crow(r, hi)]; } } while (0)
#define KBASE(t) ((t) * KVBLK)
#define MASKT(P0_, P1_, t) do { const int kb_ = KBASE(t); if (kb_ + KVBLK - 1 + 113 > qlo) { bias_tile(P0_, P1_, qm - kb_, tab); if (kb_ + KVBLK - 1 > qlo) mask_tile(P0_, P1_, qm - kb_); } } while (0)
#define SEAM_K0() do { VMWN(4); SWRITE_HK(0); SBAR(); } while (0)
    f32x16 pA0, pA1, pB0, pB1; float mnA, mnB, alA, alB; bf16x8 pa0, pa1, pa2, pa3;
    SWRITE_HV(0); SBAR();
    SLOAD_H(Kh, Vh, KBASE(1));
    SBAR(); qkt<0>(pA0, pA1, K_lds, r32, hi, map, S.qr);
    MASKT(pA0, pA1, 0); partialSM(pA0, pA1, m_reg, mnA, alA);
    VMW(); SWRITE_HK(1); SBAR();
    if (2 < NT) { SLOAD_K(Kh, KBASE(2)); SBAR(); }
    __syncthreads();
#define HALF_STEP(PX0, PX1, mnX, alX, PY0, PY1, alY, t, KB, VB) do {                                                          \
        SBAR(); qkt<KB>(PX0, PX1, K_lds, r32, hi, map, S.qr);                                                                 \
        finishSM(PY0, PY1, alY, l_reg, pa0, pa1, pa2, pa3); SBAR();                                                           \
        VMW(); SWRITE_HV(KB); SWRITE_HK(1 - KB); SBAR();                                                                      \
        SLOAD_V(Vh, KBASE((t) + 1)); if ((t) + 2 < NT) SLOAD_K(Kh, KBASE((t) + 2)); SBAR();                                   \
        pv_tile<VB>(o, vb0, pa0, pa1, pa2, pa3); MASKT(PX0, PX1, (t)); partialSM(PX0, PX1, m_reg, mnX, alX);                  \
        RESC(alX); __syncthreads(); } while (0)
    for (int t = 1; t + 1 < NT; t += 2) {
        HALF_STEP(pB0, pB1, mnB, alB, pA0, pA1, alA, t, 1, 0);
        HALF_STEP(pA0, pA1, mnA, alA, pB0, pB1, alB, t + 1, 0, 1);
    }
    SBAR(); qkt<1>(pB0, pB1, K_lds, r32, hi, map, S.qr); SBAR();
    finishSM(pA0, pA1, alA, l_reg, pa0, pa1, pa2, pa3); SBAR();
    VMW(); SWRITE_HV(1); SBAR();
    SLOAD_H(nxt.K, nxt.V, 0); SBAR();
#pragma unroll
    for (int dd = 0; dd < 4; ++dd) S.qr[dd] = ld8(nxt.Q + (size_t)(rg * 32 + r32) * AW + map * 64 + dd * 16 + hi * 8);
    SBAR();
    pv_tile<0>(o, vb0, pa0, pa1, pa2, pa3);
    MASKT(pB0, pB1, NT - 1); partialSM(pB0, pB1, m_reg, mnB, alB); RESC(alB); __syncthreads();
    finishSM(pB0, pB1, alB, l_reg, pa0, pa1, pa2, pa3); SBAR(); pv_tile<1>(o, vb0, pa0, pa1, pa2, pa3);
    SBAR(); SEAM_K0();
    if (hi == 0) li_l[r32] = l_reg; asm volatile("s_waitcnt lgkmcnt(0)" ::: "memory");
    int hi4 = 4 * hi; asm volatile("" : "+v"(hi4));
    LAS float* Xl = (LAS float*)((LAS char*)lds + OFF_X) + (rg * 32 + hi4) * 128 + r32;
    const LAS float* lil = li_l + hi4;
    const float sc1 = map ? lam : 1.f;
#pragma unroll
    for (int r = 0; r < 16; ++r) { constexpr int dummy = 0; (void)dummy; const int cr = (r & 3) + 8 * (r >> 2);
        const float rl = __builtin_amdgcn_rcpf(lil[cr]) * sc1;
#pragma unroll
        for (int d0 = 0; d0 < 4; ++d0) o[d0][r] *= rl; }
    if (map) {
#pragma unroll
        for (int r = 0; r < 16; ++r) { const int cr = (r & 3) + 8 * (r >> 2);
#pragma unroll
            for (int d0 = 0; d0 < 4; ++d0) Xl[cr * 128 + d0 * 32] = o[d0][r]; }
    }
    __syncthreads();
    if (!map) {
        float g4[4];
#pragma unroll
        for (int d0 = 0; d0 < 4; ++d0) g4[d0] = subg[d0 * 32 + r32] * osc;
        bf16* Ow = cur.O + (size_t)(rg * 32 + hi4) * DM + r32;
#pragma unroll
        for (int r = 0; r < 16; ++r) { const int cr = (r & 3) + 8 * (r >> 2); float ss = 0.f;
#pragma unroll
            for (int d0 = 0; d0 < 4; ++d0) { o[d0][r] -= Xl[cr * 128 + d0 * 32]; ss += o[d0][r] * o[d0][r]; }
            ss = sum32(ss);
            const float rs = __builtin_amdgcn_rsqf(ss * (1.f / 128.f) + EPS);
            bf16* orp = Ow + (size_t)cr * DM;
#pragma unroll
            for (int d0 = 0; d0 < 4; ++d0) { const float v = o[d0][r] * rs * g4[d0]; const float vn = nbr1(v);
                if ((r32 & 1) == 0) *(unsigned*)(orp + d0 * 32) = cvt_pk_bf16(v, vn); } }
    }
#undef RESC
#undef KBASE
#undef MASKT
#undef SEAM_K0
#undef HALF_STEP
}
#undef ROW
#undef VMW
#undef VMWN
#undef SLOAD_H
#undef SLOAD_K
#undef SLOAD_V
#undef SWRITE_HK
#undef SWRITE_HV
#undef SWRITE_H
constexpr int NSLOTS = 198;
__device__ __forceinline__ void slot_units(int slot, int& L0, int& L1) {
    if (slot < 12) { L0 = slot; L1 = -1; }
    else if (slot < 192) { const int j = slot - 12, pp = j / 12, bh = j % 12; L0 = (1 + pp) * 12 + bh; L1 = (31 - pp) * 12 + bh; }
    else { const int j = slot - 192; L0 = 192 + 2 * j; L1 = 192 + 2 * j + 1; }
}
__device__ __forceinline__ int unit_at(int k, int me, int nworkers) {
    const int slot = me + (k >> 1) * nworkers; if (slot >= NSLOTS) return -1;
    int L0, L1; slot_units(slot, L0, L1); return (k & 1) ? L1 : L0;
}
__device__ __forceinline__ void make_tables(char* lds, const float* rel_bias, const float* lamv, int layer, int t, int nt) {
    LAS float* tabs = (LAS float*)((LAS char*)lds + OFF_TAB); LAS float* cst = (LAS float*)((LAS char*)lds + OFF_C);
    for (int i = t; i < AH * 128; i += nt) { const int h = i >> 7, d = i & 127; tabs[i] = (rel_bias[t5_bucket(d) * AH + h] - rel_bias[31 * AH + h]) * (1.f / SCALE); }
    if (t < 64) { const float lam_init = 0.8f - 0.6f * expf(-0.3f * (float)layer);
        float d01 = wave_sum(lamv[t] * lamv[64 + t]), d23 = wave_sum(lamv[128 + t] * lamv[192 + t]);
        if (t == 0) cst[0] = expf(d01) - expf(d23) + lam_init; }
}
__device__ __forceinline__ void phase_static(char* lds, const bf16* qb, const bf16* kb, const bf16* vb, bf16* mixb, const float* rel_bias, const float* lamv, const float* subg, int layer, int me, int nworkers) {
    const int tid = tidx(), lane = tid & 63;
    LAS float* cst = (LAS float*)((LAS char*)lds + OFF_C);
    const float lam_init = 0.8f - 0.6f * expf(-0.3f * (float)layer);
    (void)lane; (void)rel_bias; (void)lamv;
    __syncthreads();
    const float lam = cst[0], osc = 1.f - lam_init;
    int k = 0; int L = unit_at(0, me, nworkers);
    if (L < 0) return;
    Ref cur = make_ref(L, qb, kb, vb, mixb);
    Seam S;
    prime(cur, lds, S);
    for (;;) {
        int kn = k + 1; int Ln = unit_at(kn, me, nworkers);
        if (Ln < 0 && (kn & 1)) { kn = k + 2; Ln = unit_at(kn, me, nworkers); }
        const bool last = Ln < 0;
        const Ref nxt = last ? cur : make_ref(Ln, qb, kb, vb, mixb);
        block(cur, nxt, lds, S, lam, osc, subg);
        if (last) break;
        cur = nxt; k = kn;
    }
}
#undef KSWZ
#undef SBAR
}

__device__ __forceinline__ void stats_route_tile(const Args& a, int l, int tile, char* lds, int tid) {
    typedef float f32x16 __attribute__((ext_vector_type(16)));
    const int lane = tid & 63, w = __builtin_amdgcn_readfirstlane(tid >> 6), r32 = lane & 31, hi = lane >> 5;
    LAS float* red = (LAS float*)(LAS char*)lds;
    LAS float* ssp = red + 8 * 32 * 64;
    LAS float* lg = ssp + 256;
    LAS float* rsd = lg + 2048;
    const bf16* wh = a.wrh + (size_t)l * 64 * DM; const bf16* wl = a.wrl + (size_t)l * 64 * DM;
    const size_t row = (size_t)tile * 32 + r32;
    f32x16 acc0 = {}, acc1 = {}; float ssq = 0.f;
    __syncthreads();
#pragma unroll 4
    for (int sp = 0; sp < 8; ++sp) { const int k0 = w * 256 + sp * 32 + 16 * hi;
        const bf16* hp = a.hb + row * DM + k0;
        const v4u ahh[2] = {*(const v4u*)hp, *(const v4u*)(hp + 8)};
#pragma unroll
        for (int q = 0; q < 2; ++q) { const v4u ah = ahh[q]; const unsigned au[4] = {ah.x, ah.y, ah.z, ah.w};
#pragma unroll
            for (int e = 0; e < 4; ++e) { const float lo_ = __builtin_bit_cast(float, au[e] << 16), hi_ = __builtin_bit_cast(float, au[e] & 0xffff0000u); ssq += lo_ * lo_ + hi_ * hi_; }
            const bf16x8 fah = __builtin_bit_cast(bf16x8, ah);
            const size_t fo = ((size_t)((w * 16 + 2 * sp + q) * 2) * 64 + lane) * 8;
            const bf16x8 bh0 = *(const bf16x8*)(wh + fo), bl0 = *(const bf16x8*)(wl + fo);
            const bf16x8 bh1 = *(const bf16x8*)(wh + fo + 512), bl1 = *(const bf16x8*)(wl + fo + 512);
            acc0 = __builtin_amdgcn_mfma_f32_32x32x16_bf16(fah, bh0, acc0, 0, 0, 0); acc0 = __builtin_amdgcn_mfma_f32_32x32x16_bf16(fah, bl0, acc0, 0, 0, 0);
            acc1 = __builtin_amdgcn_mfma_f32_32x32x16_bf16(fah, bh1, acc1, 0, 0, 0); acc1 = __builtin_amdgcn_mfma_f32_32x32x16_bf16(fah, bl1, acc1, 0, 0, 0); } }
    { auto rr = __builtin_amdgcn_permlane32_swap(__float_as_uint(ssq), __float_as_uint(ssq), false, false); ssq = __uint_as_float(rr[0]) + __uint_as_float(rr[1]); }
    if (hi == 0) ssp[w * 32 + r32] = ssq;
#pragma unroll
    for (int r = 0; r < 16; ++r) { const int tr = (r & 3) + 8 * (r >> 2) + 4 * hi;
        red[(w * 32 + tr) * 64 + r32] = acc0[r]; red[(w * 32 + tr) * 64 + 32 + r32] = acc1[r]; }
    __syncthreads();
#pragma unroll
    for (int q = 0; q < 4; ++q) { const int o = tid + q * NTHR; float s = 0.f;
#pragma unroll
        for (int ww = 0; ww < 8; ++ww) s += red[ww * 2048 + o];
        lg[o] = s; }
    if (tid < 32) { float s = 0.f;
#pragma unroll
        for (int ww = 0; ww < 8; ++ww) s += ssp[ww * 32 + tid];
        const float rs = 1.0f / sqrtf(s * (1.f / DM) + EPS); rsd[tid] = rs; a.rstd[tile * 32 + tid] = rs; }
    __syncthreads();
    if (tid < 32) { const int t = tile * 32 + tid; const float rs = rsd[tid]; const LAS float* L = lg + tid * 64;
        float g4[4];
#pragma unroll
        for (int j = 0; j < 4; ++j) g4[j] = L[j] * rs;
        int gi = 0; float gm = g4[0];
#pragma unroll
        for (int j = 1; j < 4; ++j) if (g4[j] > gm) { gm = g4[j]; gi = j; }
        float gs = 0.f;
#pragma unroll
        for (int j = 0; j < 4; ++j) gs += expf(g4[j] - gm);
        const float pg = 1.f / gs;
        float el[8];
#pragma unroll
        for (int j = 0; j < 8; ++j) el[j] = L[4 + gi * 8 + j] * rs;
        int i1 = 0; float v1 = el[0];
#pragma unroll
        for (int j = 1; j < 8; ++j) if (el[j] > v1) { v1 = el[j]; i1 = j; }
        int i2 = -1; float v2 = -INFINITY;
#pragma unroll
        for (int j = 0; j < 8; ++j) if (j != i1 && el[j] > v2) { v2 = el[j]; i2 = j; }
        const float e2 = expf(v2 - v1), den = 1.f + e2;
        const int e0 = gi * 8 + i1, e1 = gi * 8 + i2;
        int* cnt = (int*)(a.ctl + 65536 + l * 4096);
        LAS int* lcnt = (LAS int*)(rsd + 32); LAS int* lbase = lcnt + 32;
        lcnt[tid] = 0;
        const int r0 = atomicAdd((int*)&lcnt[e0], 1), r1 = atomicAdd((int*)&lcnt[e1], 1);
        { const int c = lcnt[tid]; lbase[tid] = c > 0 ? atomicAdd(&cnt[tid * 64], c) : 0; }
        const int p0 = lbase[e0] + r0, p1 = lbase[e1] + r1;
        a.tokl[(size_t)e0 * T + p0] = t; a.tokl[(size_t)e1 * T + p1] = t;
        a.gl[(size_t)e0 * T + p0] = pg / den; a.gl[(size_t)e1 * T + p1] = pg * e2 / den;
        a.sl[t * 2] = (e0 << 16) | p0; a.sl[t * 2 + 1] = (e1 << 16) | p1; }
}

#define XB_TMO      128
#define XB_XCNT(j)  (256  + 64 * (j))
#define XB_XSUB(j)  (1280 + 64 * (j))
#define XB_XGEN(j)  (2304 + 64 * (j))
#define XB_TOP      3328
#define XB_TOPGEN   3392
#define XCD_BAR_WORDS 3456
__device__ __forceinline__ unsigned xb_ld(unsigned* p)              { return __hip_atomic_load(p, __ATOMIC_RELAXED, __HIP_MEMORY_SCOPE_AGENT); }
__device__ __forceinline__ unsigned xb_add(unsigned* p, unsigned v) { return __hip_atomic_fetch_add(p, v, __ATOMIC_RELAXED, __HIP_MEMORY_SCOPE_AGENT); }
__device__ __forceinline__ unsigned xb_xcc_id() { return (unsigned)__builtin_amdgcn_s_getreg((3 << 11) | 20) & 0xFu; }
#define XB_SPIN(cond, bar) do { unsigned _sp = 0; while (cond) { __builtin_amdgcn_s_sleep(1); \
    if ((++_sp & 255u) == 0u) { if (xb_ld(&(bar)[XB_TMO])) break; if (_sp > XB_SPIN_CAP) { atomicAdd(&(bar)[XB_TMO], 1u); break; } } } } while (0)
struct XcdBarrier { unsigned* bar; unsigned x; volatile LAS unsigned* st; };
__device__ __forceinline__ XcdBarrier xcd_barrier_post(unsigned* bar, volatile LAS unsigned* st) {
    XcdBarrier b; b.bar = bar; b.x = xb_xcc_id(); b.st = st;
    if (tidx() == 0) (void)xb_add(&bar[XB_XCNT(b.x)], 1u);
    return b;
}
__device__ __forceinline__ void xcd_barrier_complete(unsigned* bar, unsigned x, unsigned& nloc, unsigned& nx) {
    const unsigned G = gridDim.x * gridDim.y * gridDim.z;
    unsigned sum, cnt, mine, sp = 0u;
    for (;;) {
        sum = 0u; cnt = 0u; mine = 0u;
#pragma unroll
        for (unsigned j = 0; j < 16; ++j) { const unsigned c = xb_ld(&bar[XB_XCNT(j)]); sum += c; cnt += (c > 0u) ? 1u : 0u; }
        mine = xb_ld(&bar[XB_XCNT(x)]);
        if (sum == G) break;
        __builtin_amdgcn_s_sleep(1);
        if ((++sp & 255u) == 0u) { if (xb_ld(&bar[XB_TMO])) break; if (sp > XB_SPIN_CAP) { atomicAdd(&bar[XB_TMO], 1u); break; } }
    }
    nloc = mine > 0u ? mine : 1u; nx = cnt > 0u ? cnt : 1u;
}
__device__ __forceinline__ LAS char* tab_lds_slots() { extern __shared__ __attribute__((aligned(16))) unsigned char lds_raw_[]; return (LAS char*)lds_raw_ + MISC_OFF + 12288; }
__device__ __forceinline__ void xcd_barrier(const XcdBarrier& b, char* tab_lds = nullptr, const float* tab_bias = nullptr, const float* tab_lam = nullptr, int tab_layer = 0, const int* slots = nullptr) {
    asm volatile("s_waitcnt vmcnt(0)" ::: "memory");
    __syncthreads();
    if (tab_lds != nullptr && tidx() >= 64) att::make_tables(tab_lds, tab_bias, tab_lam, tab_layer, tidx() - 64, NTHR - 64);
    if (slots != nullptr && tidx() >= 64 && tidx() < 128) ((LAS int*)((LAS char*)tab_lds_slots()))[tidx() - 64] = slots[tidx() - 64];
    if (tidx() == 0) {
        unsigned* bar = b.bar;
        __builtin_amdgcn_s_waitcnt(0);
        unsigned nloc = b.st[0], nx = b.st[1];
        if (nloc == 0u) { xcd_barrier_complete(bar, b.x, nloc, nx); b.st[0] = nloc; b.st[1] = nx; }
        const unsigned old = xb_add(&bar[XB_XSUB(b.x)], 1u);
        const unsigned gen = old / nloc;
        if (old + 1u == (gen + 1u) * nloc) {
            __builtin_amdgcn_fence(__ATOMIC_RELEASE, "agent");
            asm volatile("s_waitcnt vmcnt(0)" ::: "memory");
            const unsigned og = xb_add(&bar[XB_TOP], 1u);
            const unsigned tg = og / nx;
            if (og + 1u == (tg + 1u) * nx) xb_add(&bar[XB_TOPGEN], 1u);
            else XB_SPIN(xb_ld(&bar[XB_TOPGEN]) == tg, bar);
            __builtin_amdgcn_fence(__ATOMIC_ACQUIRE, "agent");
            xb_add(&bar[XB_XGEN(b.x)], 1u);
            asm volatile("s_waitcnt vmcnt(0)" ::: "memory");
        } else {
            XB_SPIN(xb_ld(&bar[XB_XGEN(b.x)]) == gen, bar);
            __builtin_amdgcn_fence(__ATOMIC_ACQUIRE, "agent");
            asm volatile("s_waitcnt vmcnt(0)" ::: "memory");
        }
    }
    __syncthreads();
}

__device__ __forceinline__ void sub_barrier(unsigned* ctr, unsigned n, unsigned gen, unsigned* tmo) {
    asm volatile("s_waitcnt vmcnt(0)" ::: "memory");
    __syncthreads();
    if (tidx() == 0) {
        __builtin_amdgcn_fence(__ATOMIC_RELEASE, "agent");
        asm volatile("s_waitcnt vmcnt(0)" ::: "memory");
        xb_add(ctr, 1u);
        unsigned sp = 0;
        while (xb_ld(ctr) < n * (gen + 1u)) { __builtin_amdgcn_s_sleep(1); if ((++sp & 255u) == 0u) { if (xb_ld(tmo)) break; if (sp > XB_SPIN_CAP) { atomicAdd(tmo, 1u); break; } } }
        __builtin_amdgcn_fence(__ATOMIC_ACQUIRE, "agent");
        asm volatile("s_waitcnt vmcnt(0)" ::: "memory");
    }
    __syncthreads();
}

enum { OP_PRO = 0, OP_INPROJ = 1, OP_OUTPROJ = 2, OP_STATS = 3, OP_PROMOE = 4, OP_MOEGU = 5, OP_MOEDOWN = 6, OP_COMBINE = 7, OP_ATTN = 8, OP_PROS5 = 9, OP_S5A = 10, OP_S5B = 11, OP_S5C = 12, OP_GLU = 13, OP_HG1 = 14, OP_HG2 = 15, OP_HG3 = 16, OP_MIX = 17, OP_P1 = 18 };
constexpr int NPROG = 11;
__constant__ int c_prog[NPROG] = { OP_PRO, OP_INPROJ | (0 << 8), OP_MIX | (0 << 8), OP_OUTPROJ | (0 << 8), OP_MOEGU | (0 << 8), OP_COMBINE | (0 << 8), OP_INPROJ | (1 << 8) | 0x10000, OP_MIX | (1 << 8), OP_OUTPROJ | (1 << 8), OP_MOEGU | (1 << 8), OP_COMBINE | (1 << 8) };

__global__ void __launch_bounds__(NTHR, 2) mega(KArgs a) {
    extern __shared__ __attribute__((aligned(16))) unsigned char lds_raw[];
    LAS unsigned char* lds = (LAS unsigned char*)lds_raw;
    const int G = gridDim.x;
    volatile LAS unsigned* bst = (volatile LAS unsigned*)(lds + LDS_BYTES - 64);
    if (tidx() < 16) bst[tidx()] = 0u;
    __syncthreads();
    unsigned* barw = (unsigned*)(a.ws + O_CTL) + 4096;
    XcdBarrier bar; bar.bar = barw; bar.x = 0; bar.st = bst;
    if (a.nprog > 1) bar = xcd_barrier_post(barw, bst);
#define PH_IDS const int tid = tidx(), lane = tid & 63, wave = __builtin_amdgcn_readfirstlane(tid >> 6); \
    const int vcu = (G % 8 == 0) ? (bx % 8) * (G / 8) + bx / 8 : bx; const int gw = vcu * NWAVES + wave, NGW = G * NWAVES; (void)lane; (void)gw; (void)NGW; (void)tid
  const int pi_lo = a.pi0, pi_hi = a.pi0 + a.nprog;
  if (pi_lo == 0) {
    typedef const __attribute__((address_space(4))) KArgs* KP;
    KP kp = (KP)__builtin_amdgcn_kernarg_segment_ptr(); asm volatile("" : "+s"(kp));
    Args A;
#pragma unroll
    for (int i_ = 0; i_ < 25; ++i_) A.in[i_] = kp->in[i_];
    A.out = kp->out; fill_ws(A, kp->ws);
    int bx = blockIdx.x; asm volatile("" : "+s"(bx));
    PH_IDS;
    for (int it = bx; it < DEPTH * SG; it += G) s5_tables(A, it / SG, it % SG, (LAS float*)lds, tid);
    LAS float* scr = (LAS float*)(lds + 65536 + wave * 8448);
    { constexpr int I_G = (DM / 64) * (DE / 32), I_D = (DE / 64) * (DM / 32);
      { MkMoeD mk{A.in[23], A.wd_t, -(DEPTH * NE * I_D)}; tr_loop<false>(mk, DEPTH * NE * I_D, gw, NGW, scr, lane); }
      { MkMoeGU mk{A.in[21], A.in[22], A.in[4], A.wgu_t, -(DEPTH * NE * 2 * I_G)}; tr_loop<true>(mk, NE * 2 * I_G - 2 * CONV_S, gw, NGW, scr, lane); }
      { MkMoeGU mk{A.in[21], A.in[22], A.in[4], A.wgu_t, -(NE * 2 * I_G)}; tr_loop<true>(mk, NE * 2 * I_G, gw, NGW, scr, lane); } }
    { constexpr int I_IN = (DM / 64) * (INC / 32), I_OUT = (DM / 64) * (DM / 32);
      { MkIn mk{A.in[1], A.in[3], A.win_t, 0}; tr_loop<true>(mk, DEPTH * I_IN, gw, NGW, scr, lane); }
      { MkOut mk{A.in[2], A.wout_t, 0}; tr_loop<false>(mk, DEPTH * I_OUT, gw, NGW, scr, lane); } }
    for (int m0 = gw * 4; m0 < T; m0 += NGW * 4)
        for (int m = m0; m < m0 + 4 && m < T; ++m) stats_row(A.in[0] + (size_t)m * DM, A.hb + (size_t)m * DM, A.rstd + m, lane);
    for (int i = gw * 64 + lane; i < DEPTH * (INCP - INC) * DM / 8; i += NGW * 64) {
        const int ll = i / ((INCP - INC) * DM / 8), r = i % ((INCP - INC) * DM / 8);
        *(GAS v4u*)(A.win_t + (size_t)ll * INCP * DM + (size_t)INC * DM + (size_t)r * 8) = (v4u){0u, 0u, 0u, 0u};
    }
    for (int i = gw * 64 + lane; i < DEPTH * HW; i += NGW * 64) {
        const int ll = i / HW, ch = i % HW;
        float lb = 0.f;
        if (ll == 1) { const float l0 = A.in[17][ch], l1 = A.in[17][HW + ch]; lb = 1.f / (1.f + expf(l0 - l1)); }
        A.lbt[i * 2] = lb; A.lbt[i * 2 + 1] = 1.f - lb;
    }
    for (int i = gw * 64 + lane; i < DEPTH * 64 * DM; i += NGW * 64) { const int ll = i / (64 * DM), q = i % (64 * DM);
        const int jj = q & 7, ln = (q >> 3) & 63, nt = (q >> 9) & 1, ks = q >> 10;
        const int j = nt * 32 + (ln & 31), k = (ks >> 1) * 32 + 16 * (ln >> 5) + 8 * (ks & 1) + jj;
        float wv = 0.f;
        if (j < 4) wv = A.in[19][((size_t)ll * DM + k) * NGRP + j]; else if (j < 36) wv = A.in[20][((size_t)ll * DM + k) * NE + (j - 4)];
        wv *= A.in[4][ll * DM + k];
        const unsigned hb_ = f2bf(wv); const float lo = wv - __builtin_bit_cast(float, hb_ << 16);
        A.wrh[i] = (bf16)hb_; A.wrl[i] = (bf16)f2bf(lo); }
    { constexpr int I_GL = (SW / 64) * (SW / 32);
      MkGlu mk{A.in[16], A.wglu_t}; tr_loop<false>(mk, DEPTH * I_GL, gw, NGW, scr, lane);
      for (int i = gw * 64 + lane; i < DEPTH * 128 * SW / 8; i += NGW * 64) { const int ll = i / (128 * SW / 8), r = i % (128 * SW / 8);
          *(GAS v4u*)(A.wglu_t + (size_t)ll * 768 * SW + (size_t)SW * SW + (size_t)r * 8) = (v4u){0u, 0u, 0u, 0u}; } }
  }
  for (int pi = (pi_lo > 1 ? pi_lo : 1); pi < pi_hi; ++pi) {
    const int pw = c_prog[pi], op_ = pw & 255, l = (pw >> 8) & 255;
    if (pi > pi_lo && !(pw & 0x10000)) {
        if (op_ == OP_MIX) { typedef const __attribute__((address_space(4))) KArgs* KQ; KQ kq = (KQ)__builtin_amdgcn_kernarg_segment_ptr(); asm volatile("" : "+s"(kq));
            xcd_barrier(bar, (char*)lds_raw, kq->in[5], kq->in[6] + l * 4 * DK, l); }
        else if (op_ == OP_COMBINE && G == T / 32) { typedef const __attribute__((address_space(4))) KArgs* KQ; KQ kq = (KQ)__builtin_amdgcn_kernarg_segment_ptr(); asm volatile("" : "+s"(kq));
            xcd_barrier(bar, nullptr, nullptr, nullptr, 0, (const int*)((const char*)kq->ws + O_SL) + (size_t)blockIdx.x * 64); }
        else xcd_barrier(bar); }
    typedef const __attribute__((address_space(4))) KArgs* KP;
    KP kp = (KP)__builtin_amdgcn_kernarg_segment_ptr(); asm volatile("" : "+s"(kp));
    Args A;
#pragma unroll
    for (int i_ = 0; i_ < 25; ++i_) A.in[i_] = kp->in[i_];
    A.out = kp->out; fill_ws(A, kp->ws);
    int bx = blockIdx.x; asm volatile("" : "+s"(bx));
    int G_ = gridDim.x; asm volatile("" : "+s"(G_)); const int G = G_;

    if (op_ == OP_INPROJ) {
        pg8::DenseOrder S; S.init(A.hb, A.win_t + (size_t)l * INCP * DM, T, INCP, DM, G, bx);
        if (l > 0) { S.ready = A.ctl + 49152 + (l - 1) * 1024; S.need = 64u; S.tmo = A.ctl + 4096 + XB_TMO; }
        EpiProj E{A.rstd, A.qb, A.kb, A.vb, A.ug, A.hq, A.hk, A.hv, A.hg, A.hlogf, A.lbt + l * HW * 2};
        pg8::gemm_phase<EpiProj, pg8::DenseOrder, false>(lds, S, E);
        { const int nun = (T / 256) * (INCP / 256), full = nun / G, nidle = G - (nun - full * G);
          if (nidle < G && bx >= G - nidle) {
              __syncthreads();
              const int tid_ = tidx(), lane_ = tid_ & 63, wave_ = __builtin_amdgcn_readfirstlane(tid_ >> 6);
              LAS float* scr = (LAS float*)(lds + 65536 + wave_ * 8448);
              constexpr int I_G = (DM / 64) * (DE / 32);
              MkMoeGU mk{A.in[21], A.in[22], A.in[4], A.wgu_t, NE * 2 * I_G + l * CONV_S};
              tr_loop<true>(mk, CONV_S, (bx - (G - nidle)) * NWAVES + wave_, nidle * NWAVES, scr, lane_);
              __syncthreads(); } }
    } else if (op_ == OP_OUTPROJ) {
        unsigned* rt = A.ctl + 28672 + l * 1024; unsigned* tmo = A.ctl + 4096 + XB_TMO;
        { pg8::DenseOrder S; S.init(A.mixb, A.wout_t + (size_t)l * DM * DM, T, DM, DM, G, bx);
          EpiResid E{A.hb, rt};
          pg8::gemm_phase<EpiResid, pg8::DenseOrder, false>(lds, S, E); }
        for (int tile = bx; tile < T / 32; tile += G) {
            __syncthreads();
            if (tidx() == 0) { unsigned sp = 0;
                while (xb_ld(rt + 16 * (tile >> 3)) < 64u) { __builtin_amdgcn_s_sleep(1); if ((++sp & 255u) == 0u) { if (xb_ld(tmo)) break; if (sp > XB_SPIN_CAP) { atomicAdd(tmo, 1u); break; } } }
                __builtin_amdgcn_fence(__ATOMIC_ACQUIRE, "agent");
                asm volatile("s_waitcnt vmcnt(0)" ::: "memory"); }
            __syncthreads();
            stats_route_tile(A, l, tile, (char*)lds_raw, tidx());
        }
    } else if (op_ == OP_MIX) {
        const int WG = G >= 116 ? 58 : G / 2, NA = G - WG;
        unsigned* sbc = A.ctl + 12288 + l * 64; unsigned* tmo = A.ctl + 4096 + XB_TMO;
        unsigned* p1c = A.ctl + 20480 + l * 64; unsigned* hq1 = A.ctl + 24576 + l * 64;
        volatile LAS int* nu = (volatile LAS int*)(lds + MISC_OFF + 4096);
        if (bx >= NA) { const int wb = bx - NA;
            S5Order S; S.A = A.ug; S.Bt = A.s5et + (size_t)l * SG * 256 * 512; S.K = 512; S.lda = S5LD; S.gstrideB = (size_t)256 * 512; S.NP = 1; S.G = WG; S.c = wb;
            EpiS5A E{A.xend};
            pg8::gemm_phase<EpiS5A, S5Order, false>(lds, S, E); }
        { unsigned pf = 0u;
          __syncthreads();
          if (tidx() == 0) nu[0] = (int)atomicAdd(hq1, 1u);
          __syncthreads();
          int u = nu[0];
          for (int k = 0; u < hg::NUN; ++k)
              u = hg::hg1_unit(A, u, (char*)lds_raw, tidx(), bx >= NA || k + 1 < 2, hq1, nu, pf);
          asm volatile("s_waitcnt vmcnt(0)" ::: "memory"); asm volatile("" :: "v"(pf)); }
        asm volatile("s_waitcnt vmcnt(0)" ::: "memory");
        __syncthreads();
        if (tidx() == 0) { __builtin_amdgcn_fence(__ATOMIC_RELEASE, "agent"); asm volatile("s_waitcnt vmcnt(0)" ::: "memory"); xb_add(p1c, 1u); }
        if (bx < NA) {
            att::phase_static((char*)lds_raw, A.qb, A.kb, A.vb, A.mixb, A.in[5], A.in[6] + l * 4 * DK, A.in[7] + l * DV, l, bx, NA);
            __syncthreads();
            if (tidx() == 0) { unsigned sp = 0;
                while (xb_ld(sbc) < (unsigned)WG) { __builtin_amdgcn_s_sleep(1); if ((++sp & 255u) == 0u) { if (xb_ld(tmo)) break; if (sp > XB_SPIN_CAP) { atomicAdd(tmo, 1u); break; } } }
                __builtin_amdgcn_fence(__ATOMIC_ACQUIRE, "agent");
                asm volatile("s_waitcnt vmcnt(0)" ::: "memory"); }
            __syncthreads();
        } else {
            const int wb = bx - NA;
            if (tidx() == 0) { unsigned sp = 0;
                while (xb_ld(p1c) < (unsigned)G) { __builtin_amdgcn_s_sleep(1); if ((++sp & 255u) == 0u) { if (xb_ld(tmo)) break; if (sp > XB_SPIN_CAP) { atomicAdd(tmo, 1u); break; } } }
                __builtin_amdgcn_fence(__ATOMIC_ACQUIRE, "agent");
                asm volatile("s_waitcnt vmcnt(0)" ::: "memory"); }
            __syncthreads();
            for (int it = wb; it < BATCH * SG; it += WG) s5_scan_unit(A, l, it / SG, it % SG, (LAS float*)lds, tidx());
            hg::hg2(A, wb * NTHR + tidx(), WG * NTHR);
            sub_barrier(sbc, (unsigned)WG, 0u, tmo);
            { S5Order S; S.A = A.ug; S.Bt = A.s5mf + (size_t)l * SG * 512 * 640; S.K = 640; S.lda = S5LD; S.gstrideB = (size_t)512 * 640; S.NP = 2; S.G = WG; S.c = wb;
              EpiS5C E{A.zb};
              pg8::gemm_phase<EpiS5C, S5Order, false>(lds, S, E); }
            sub_barrier(sbc, (unsigned)WG, 1u, tmo);
            { pg8::DenseOrder S; S.init(A.zb, A.wglu_t + (size_t)l * 768 * SW, T, 768, SW, WG, wb);
              EpiGLU E{A.zb, A.mixb};
              pg8::gemm_phase<EpiGLU, pg8::DenseOrder, false>(lds, S, E); }
        }
        { unsigned* hq3 = A.ctl + 16384 + l * 64;
          unsigned pf0 = 0u, pf1 = 0u;
          __syncthreads();
          if (tidx() == 0) nu[0] = (int)atomicAdd(hq3, 1u);
          __syncthreads();
          int u = nu[0];
          while (u < hg::NUN) u = hg::hg3_unit(A, l, u, (char*)lds_raw, tidx(), hq3, nu, pf0, pf1);
          asm volatile("s_waitcnt vmcnt(0)" ::: "memory"); asm volatile("" :: "v"(pf0), "v"(pf1)); }
    } else if (op_ == OP_MOEGU) {
        PH_IDS;
        LAS int* tpre = (LAS int*)(lds + MISC_OFF); LAS int* rowsl = (LAS int*)(lds + MISC_OFF + 1024);
        const int* cnt = (const int*)(A.ctl + 65536 + l * 4096);
        unsigned* ready = A.ctl + 32768 + l * 2048; unsigned* tmo = A.ctl + 4096 + XB_TMO;
        moe_tiles(cnt, tpre, tid);
        const int nGU = tpre[NE] * 4, H = nGU > G ? (nGU - G < G ? nGU - G : G) : 0;
        { MoeOrder S; S.A = A.hb; S.Bt = A.wgu_t + (size_t)l * NE * 1024 * DM; S.K = DM; S.lda = DM; S.estride = (size_t)1024 * DM; S.NP = 4; S.G = G; S.c = moe_rank(bx, 0, G); S.gather = true; S.tpre = tpre; S.rowsl = rowsl;
          S.ready = nullptr; S.need = 0; S.tmo = tmo;
          { pg8::Unit u; for (int i = 0; S.next(i, u); ++i) { const int ce = cnt[u.e * 64], p0 = (u.pm - tpre[u.e]) * 256;
              for (int r = tid; r < 256; r += NTHR) { const int pos = p0 + r; rowsl[i * 256 + r] = A.tokl[(size_t)u.e * T + (pos < ce ? pos : 0)]; } } }
          __syncthreads();
          EpiGU E{A.rstd, A.hmid, rowsl, ready};
          pg8::gemm_phase<EpiGU, MoeOrder, true>(lds, S, E); }
        { MoeOrder S; S.A = A.hmid; S.Bt = A.wd_t + (size_t)l * NE * DM * DE; S.K = DE; S.lda = DE; S.estride = (size_t)DM * DE; S.NP = 8; S.gather = false; S.tpre = tpre; S.rowsl = nullptr;
          { const int r = moe_rank(bx, 0, G);
            if (H > 0 && H < G) { S.G = G - H; S.c = r >= H ? r - H : -1; } else { S.G = G; S.c = r; } }
          S.ready = ready; S.need = 32u; S.tmo = tmo;
          EpiDown E{A.gl, cnt, A.ybuf, tpre};
          pg8::gemm_phase<EpiDown, MoeOrder, false>(lds, S, E); }
    } else if (op_ == OP_COMBINE) {
        PH_IDS;
        LAS int* tpre = (LAS int*)(lds + MISC_OFF);
#ifdef MK_PER_PHASE
        { const int* cnt = (const int*)(A.ctl + 65536 + l * 4096); moe_tiles(cnt, tpre, tid); }
#endif
        const bool lastl = (l == DEPTH - 1);
        const float* gfin = A.in[24];
        unsigned* rtc = A.ctl + 49152 + l * 1024;
        for (int tile = bx; tile < T / 32; tile += G) {
          const int m0 = tile * 32 + wave * 4;
          int s0a[4], s1a[4];
#pragma unroll
          for (int k4 = 0; k4 < 4; ++k4) {
              if (G == T / 32) { const LAS int* sq = (const LAS int*)(lds + MISC_OFF + 12288) + (wave * 4 + k4) * 2; s0a[k4] = sq[0]; s1a[k4] = sq[1]; }
              else { s0a[k4] = A.sl[(m0 + k4) * 2]; s1a[k4] = A.sl[(m0 + k4) * 2 + 1]; } }
          v2u X[2][8], P[2][8], Q[2][8];
#define CMB_LOAD(k4, bf) do { const int s0 = s0a[k4], s1 = s1a[k4];                                                                    \
            const size_t r0 = (size_t)tpre[s0 >> 16] * 256 + (s0 & 0xffff), r1 = (size_t)tpre[s1 >> 16] * 256 + (s1 & 0xffff);         \
            const GAS v2u* xr = (const GAS v2u*)(A.hb + (size_t)(m0 + (k4)) * DM) + lane;                                              \
            const GAS v2u* y0 = (const GAS v2u*)(A.ybuf + r0 * DM) + lane; const GAS v2u* y1 = (const GAS v2u*)(A.ybuf + r1 * DM) + lane; \
            _Pragma("unroll") for (int j = 0; j < 8; ++j) { X[bf][j] = xr[64 * j]; P[bf][j] = y0[64 * j]; Q[bf][j] = y1[64 * j]; } } while (0)
          CMB_LOAD(0, 0);
#pragma unroll
          for (int k4 = 0; k4 < 4; ++k4) { const int m = m0 + k4; const int bf = k4 & 1;
            if (k4 == 0) CMB_LOAD(1, 1); else if (k4 == 1) CMB_LOAD(2, 0); else if (k4 == 2) CMB_LOAD(3, 1);
            f32x4 v[8]; float ss = 0.f;
#pragma unroll
            for (int j = 0; j < 8; ++j) { const v2u x = X[bf][j], p = P[bf][j], q = Q[bf][j];
                v[j].x = __builtin_bit_cast(float, x.x << 16) + __builtin_bit_cast(float, p.x << 16) + __builtin_bit_cast(float, q.x << 16);
                v[j].y = __builtin_bit_cast(float, x.x & 0xffff0000u) + __builtin_bit_cast(float, p.x & 0xffff0000u) + __builtin_bit_cast(float, q.x & 0xffff0000u);
                v[j].z = __builtin_bit_cast(float, x.y << 16) + __builtin_bit_cast(float, p.y << 16) + __builtin_bit_cast(float, q.y << 16);
                v[j].w = __builtin_bit_cast(float, x.y & 0xffff0000u) + __builtin_bit_cast(float, p.y & 0xffff0000u) + __builtin_bit_cast(float, q.y & 0xffff0000u);
                if (!lastl) { v2u w; w.x = pk2(v[j].x, v[j].y); w.y = pk2(v[j].z, v[j].w);
                    v[j].x = __builtin_bit_cast(float, w.x << 16); v[j].y = __builtin_bit_cast(float, w.x & 0xffff0000u); v[j].z = __builtin_bit_cast(float, w.y << 16); v[j].w = __builtin_bit_cast(float, w.y & 0xffff0000u); }
                ss += (v[j].x * v[j].x + v[j].y * v[j].y) + (v[j].z * v[j].z + v[j].w * v[j].w); }
            ss = wave_sum(ss);
            const float rs = 1.0f / sqrtf(ss * (1.f / DM) + EPS);
            if (lastl) {
                GAS f32x4* o = (GAS f32x4*)(A.out + (size_t)m * DM) + lane;
#pragma unroll
                for (int j = 0; j < 8; ++j) { const f32x4 g = *((const GAS f32x4*)gfin + lane + 64 * j); o[64 * j] = v[j] * rs * g; }
            } else {
                if (lane == 0) __hip_atomic_store(A.rstd + m, rs, __ATOMIC_RELAXED, __HIP_MEMORY_SCOPE_AGENT);
                bf16* o8 = A.hb + (size_t)m * DM + lane * 4;
#pragma unroll
                for (int j = 0; j < 8; ++j) { v2u w; w.x = pk2(v[j].x, v[j].y); w.y = pk2(v[j].z, v[j].w); bf16* dp = o8 + 256 * j;
                    asm volatile("global_store_dwordx2 %0, %1, off sc1\n\ts_nop 1" :: "v"(dp), "v"(w) : "memory"); }
            }
          }
#undef CMB_LOAD
          if (!lastl) {
              asm volatile("s_waitcnt vmcnt(0)" ::: "memory");
              if (lane == 0) __hip_atomic_fetch_add(rtc + 16 * (tile >> 3), 1u, __ATOMIC_RELAXED, __HIP_MEMORY_SCOPE_AGENT);
          }
        }
    }
  }
}

extern "C" void kernel_launch(void* const* d_in, const int* in_sizes, int n_in, void* d_out, int out_size, void* d_ws, size_t ws_size, hipStream_t stream) {
    static int grid = 0;
    if (grid == 0) {
        int dev = 0, cus = 0;
        if (hipGetDevice(&dev) != hipSuccess || hipDeviceGetAttribute(&cus, hipDeviceAttributeMultiprocessorCount, dev) != hipSuccess) { fprintf(stderr, "kernel_launch: device query failed\n"); grid = -1; return; }
        if (hipFuncSetAttribute((const void*)mega, hipFuncAttributeMaxDynamicSharedMemorySize, LDS_BYTES) != hipSuccess) { fprintf(stderr, "kernel_launch: hipFuncSetAttribute failed\n"); grid = -1; return; }
        grid = cus;
    }
    if (grid < 0) return;
    const float* const* in = (const float* const*)d_in;
    float* out = (float*)d_out;

    if (O_END > ws_size) { fprintf(stderr, "kernel_launch: workspace too small: need %zu have %zu\n", (size_t)O_END, ws_size); return; }
    KArgs a{};
    for (int i = 0; i < 25; ++i) a.in[i] = in[i];
    a.out = out; a.ws = (unsigned char*)d_ws;
    if (hipMemsetAsync((unsigned char*)d_ws + O_CTL, 0, 1 << 20, stream) != hipSuccess) { fprintf(stderr, "kernel_launch: memset failed\n"); return; }
#ifdef MK_PER_PHASE
    for (int i = 0; i < NPROG; ++i) { KArgs b = a; b.pi0 = i; b.nprog = 1; hipLaunchKernelGGL(mega, dim3(grid), dim3(NTHR), LDS_BYTES, stream, b); }
#else
    a.pi0 = 0; a.nprog = NPROG;
    hipLaunchKernelGGL(mega, dim3(grid), dim3(NTHR), LDS_BYTES, stream, a);
#endif
}
```

```cpp
#include <hip/hip_runtime.h>
#include <cstdio>
#include <cstdint>
#include <cmath>

constexpr int DM = 2048, BATCH = 2, SEQ = 4096, DEPTH = 2, T = BATCH * SEQ;
constexpr int AH = 6, DK = 64, DV = 128, AW = 768;
constexpr int SG = 40, SC = 16, SN = 64, SW = 640;
constexpr int HH = 5, HD = 128, HW = 640;
constexpr int INC = 5504, INCP = 5632;
constexpr int NGRP = 4, EPG = 8, NE = 32, DE = 512;
constexpr float EPS = 1e-6f;
constexpr int S5L = 32, S5NC = T / S5L, S5LD = 640;

typedef unsigned short bf16;
#define GAS __attribute__((address_space(1)))
#define LAS __attribute__((address_space(3)))
typedef unsigned v4u __attribute__((ext_vector_type(4)));
typedef unsigned v2u __attribute__((ext_vector_type(2)));
typedef float f32x4 __attribute__((ext_vector_type(4)));
typedef short bf16x8 __attribute__((ext_vector_type(8)));

__device__ __forceinline__ int lane_id_() { unsigned m = ~0u; asm volatile("" : "+s"(m)); return (int)__builtin_amdgcn_mbcnt_hi(m, __builtin_amdgcn_mbcnt_lo(m, 0u)); }
__device__ __forceinline__ int tidx() {
    int w = __builtin_amdgcn_readfirstlane((int)(threadIdx.x >> 6)); asm volatile("" : "+s"(w));
    return (w << 6) | lane_id_(); }
__device__ __forceinline__ float shx(float v, int o) { return __builtin_bit_cast(float, __builtin_amdgcn_ds_bpermute((lane_id_() ^ o) << 2, __builtin_bit_cast(int, v))); }
template <int CTRL> __device__ __forceinline__ float dppf(float v) { return __builtin_bit_cast(float, __builtin_amdgcn_update_dpp(0, __builtin_bit_cast(int, v), CTRL, 0xF, 0xF, false)); }
__device__ __forceinline__ float nbr1(float v) { return dppf<0xB1>(v); }
__device__ __forceinline__ float sum32(float v) {
    v += dppf<0xB1>(v); v += dppf<0x4E>(v); v += dppf<0x141>(v); v += dppf<0x140>(v);
    auto rr = __builtin_amdgcn_permlane16_swap(__float_as_uint(v), __float_as_uint(v), false, false);
    return __uint_as_float(rr[0]) + __uint_as_float(rr[1]); }
__device__ __forceinline__ float max32(float v) {
    v = fmaxf(v, dppf<0xB1>(v)); v = fmaxf(v, dppf<0x4E>(v)); v = fmaxf(v, dppf<0x141>(v)); v = fmaxf(v, dppf<0x140>(v));
    auto rr = __builtin_amdgcn_permlane16_swap(__float_as_uint(v), __float_as_uint(v), false, false);
    return fmaxf(__uint_as_float(rr[0]), __uint_as_float(rr[1])); }
__device__ __forceinline__ float wave_sum(float v) {
    v = sum32(v);
    auto rr = __builtin_amdgcn_permlane32_swap(__float_as_uint(v), __float_as_uint(v), false, false);
    return __uint_as_float(rr[0]) + __uint_as_float(rr[1]); }
__device__ __forceinline__ float wave_max(float v) {
    v = max32(v);
    auto rr = __builtin_amdgcn_permlane32_swap(__float_as_uint(v), __float_as_uint(v), false, false);
    return fmaxf(__uint_as_float(rr[0]), __uint_as_float(rr[1])); }
__device__ __forceinline__ float sigmoidf_(float x) { return __builtin_amdgcn_rcpf(1.f + __builtin_amdgcn_exp2f(-1.4426950408889634f * x)); }
__device__ __forceinline__ int t5_bucket(int n) {
    if (n < 16) return n;
    int large = 16 + (int)(logf((float)n / 16.f) / 2.0794415416798357f * 16.f);
    return large < 31 ? large : 31;
}
__device__ __forceinline__ unsigned f2bf(float f) { unsigned u = __builtin_bit_cast(unsigned, f); return (u + 0x7fffu + ((u >> 16) & 1u)) >> 16; }
__device__ __forceinline__ unsigned pk2(float lo, float hi) { unsigned r; asm("v_cvt_pk_bf16_f32 %0, %1, %2" : "=v"(r) : "v"(lo), "v"(hi)); return r; }
__device__ __forceinline__ float bf2f(bf16 v) { return __builtin_bit_cast(float, (unsigned)v << 16); }
__device__ __forceinline__ unsigned cvt_pk_bf16(float lo, float hi) { unsigned r; asm volatile("v_cvt_pk_bf16_f32 %0, %1, %2" : "=v"(r) : "v"(lo), "v"(hi)); return r; }
#define LDS_WAIT() asm volatile("s_waitcnt lgkmcnt(0)" ::: "memory")
#define VM_WAIT() asm volatile("s_waitcnt vmcnt(0)" ::: "memory")

namespace pg8 {
constexpr int BM = 256, BK = 64, HALF = 128, HTB = HALF * BK * 2  , STAGE_BYTES = 8 * HTB, NXCD = 8, WGM = 8;
__host__ __device__ __forceinline__ int lds_byte(int r, int c) { const int st = (r >> 4) * 2 + (c >> 5), rr = r & 15, cc = c & 31, ob = rr * 64 + cc * 2; return st * 1024 + (ob ^ (((ob >> 9) & 1) << 5)); }
__host__ __device__ __forceinline__ void stage_rc(int b, int& R, int& C) { const int st = b / 1024, sb = b % 1024, swz = sb ^ (((sb >> 9) & 1) << 5); R = (st >> 1) * 16 + swz / 64; C = (st & 1) * 32 + (swz % 64) / 2; }
__host__ __device__ __forceinline__ int perm32(int rho) { const int n = rho >> 4, i = rho & 15; return 8 * (i >> 2) + 4 * n + (i & 3); }

struct Unit { int pm, pn, e, li; };

struct DenseOrder {
    const bf16* A; const bf16* Bt; int K, lda;
    int nM, nN, nwg, G, c;
    unsigned* ready = nullptr; unsigned need = 0; unsigned* tmo = nullptr;
    __device__ __forceinline__ void init(const bf16* A_, const bf16* Bt_, int M, int N, int K_, int G_, int c_) { A = A_; Bt = Bt_; K = K_; lda = K_; nM = M / BM; nN = N / BM; nwg = nM * nN; G = G_; c = c_; }
    __device__ __forceinline__ bool next(int i, Unit& u) const {
        const long L = (long)i * G + c; if (L >= nwg) return false;
        int wgid = (int)L; { const int q = nwg / NXCD, r = nwg % NXCD, xcd = wgid % NXCD, off = wgid / NXCD; wgid = (xcd < r ? xcd * (q + 1) : r * (q + 1) + (xcd - r) * q) + off; }
        const int nig = WGM * nN, gid = wgid / nig, fm = gid * WGM, gsz = (nM - fm) < WGM ? (nM - fm) : WGM;
        u.pm = fm + ((wgid % nig) % gsz); u.pn = (wgid % nig) / gsz; u.e = 0; u.li = i; return true;
    }
    __device__ __forceinline__ const char* a_tile(const Unit& u) const { return (const char*)A + (size_t)u.pm * BM * lda * 2; }
    __device__ __forceinline__ const char* b_tile(const Unit& u) const { return (const char*)Bt + (size_t)u.pn * BM * K * 2; }
    __device__ __forceinline__ const LAS int* a_rows(const Unit&) const { return nullptr; }
    __device__ __forceinline__ void a_ready(const Unit& u) const {
        if (ready == nullptr) return;
        if (tidx() < 64) {
            unsigned sp = 0;
            while ((unsigned)__builtin_amdgcn_readfirstlane(__hip_atomic_load(ready + 16 * u.pm, __ATOMIC_RELAXED, __HIP_MEMORY_SCOPE_AGENT)) < need) {
                __builtin_amdgcn_s_sleep(2);
                if ((++sp & 255u) == 0u) { if (__hip_atomic_load(tmo, __ATOMIC_RELAXED, __HIP_MEMORY_SCOPE_AGENT)) break; if (sp > (1u << 18)) { if (tidx() == 0) atomicAdd(tmo, 1u); break; } } }
            __builtin_amdgcn_fence(__ATOMIC_ACQUIRE, "agent");
            asm volatile("s_waitcnt vmcnt(0)" ::: "memory");
        }
        asm volatile("" ::: "memory"); __builtin_amdgcn_s_barrier(); asm volatile("" ::: "memory");
    }
};

#define PG8_LAS LAS
template <class Epi, class Sched, bool GATHER>
__device__ __forceinline__ void gemm_phase(PG8_LAS unsigned char* lds, const Sched& S, const Epi& E) {
    const int tid = tidx(), wid = __builtin_amdgcn_readfirstlane(tid >> 6), lane = tid & 63, wr = wid >> 2, wc = wid & 3, fr = lane & 15, fq = lane >> 4;
    const int K = S.K, nt = K / BK, lda = S.lda;
    unsigned voffA[2], voffB[2]; int rA[2], cA2[2];
#pragma unroll
    for (int i = 0; i < 2; ++i) { int R, C; stage_rc(tid * 16 + i * 8192, R, C); const int Rb = Epi::PERM ? ((R & ~31) + perm32(R & 31)) : R;
        rA[i] = R; cA2[i] = C * 2; voffA[i] = (unsigned)(R * lda + C) * 2u; voffB[i] = (unsigned)(Rb * K + C) * 2u; }
    const size_t kstep = (size_t)(BK * 2);
    const size_t hstep = (size_t)HALF * K * 2, hstepA = (size_t)HALF * lda * 2;
    const unsigned ldsw = (unsigned)wid * 1024u;
    const int aoff = lds_byte(wr * 64 + fr, fq * 8), boff = lds_byte(wc * 32 + fr, fq * 8);
#define PG8_SA(b, h) (((b) * 2 + (h)) * HTB)
#define PG8_SB(b, h) ((4 + (b) * 2 + (h)) * HTB)
#define PG8_STAGE(bufoff, gbase, voff) do { _Pragma("unroll") for (int _i = 0; _i < 2; ++_i) \
        __builtin_amdgcn_global_load_lds((const unsigned*)((const char*)(gbase) + (voff)[_i]), (PG8_LAS unsigned*)(lds + (bufoff) + ldsw + _i * 8192), 16, 0, 0); } while (0)
#define PG8_STAGE_A(bufoff, ptr, h, VO) do { if constexpr (GATHER) { PG8_STAGE(bufoff, ptr, VO[h]); } else { PG8_STAGE(bufoff, (ptr) + (h) * hstepA, voffA); } } while (0)
#define PG8_LDA(dst, b, h) do { _Pragma("unroll") for (int m = 0; m < 4; ++m) _Pragma("unroll") for (int k = 0; k < 2; ++k) dst[m][k] = *(const PG8_LAS bf16x8*)(lds + PG8_SA(b, h) + aoff + m * 2048 + k * 1024); } while (0)
#define PG8_LDB(dst, b, h) do { _Pragma("unroll") for (int n = 0; n < 2; ++n) _Pragma("unroll") for (int k = 0; k < 2; ++k) dst[n][k] = *(const PG8_LAS bf16x8*)(lds + PG8_SB(b, h) + boff + n * 2048 + k * 1024); } while (0)
#define PG8_MMA(ai, bj, At, Bt) do { __builtin_amdgcn_s_setprio(1); _Pragma("unroll") for (int m = 0; m < 4; ++m) _Pragma("unroll") for (int n = 0; n < 2; ++n) _Pragma("unroll") for (int k = 0; k < 2; ++k) \
        acc[ai][bj][m][n] = __builtin_amdgcn_mfma_f32_16x16x32_bf16(Bt[n][k], At[m][k], acc[ai][bj][m][n], 0, 0, 0); __builtin_amdgcn_s_setprio(0); } while (0)
#define PG8_WAIT_V(n) asm volatile("s_waitcnt vmcnt(" #n ")" ::: "memory")
#define PG8_WAIT_L(n) asm volatile("s_waitcnt lgkmcnt(" #n ")" ::: "memory")
#define PG8_BAR __builtin_amdgcn_s_barrier()
#define PG8_SCHED __builtin_amdgcn_sched_barrier(0)
    Unit cur, nxt;
    if (!S.next(0, cur)) return;
    f32x4 acc[2][2][4][2];
    float z0 = 0.f; asm volatile("" : "+v"(z0));
#pragma unroll
    for (int a = 0; a < 2; ++a)
#pragma unroll
        for (int b = 0; b < 2; ++b)
#pragma unroll
            for (int m = 0; m < 4; ++m)
#pragma unroll
                for (int n = 0; n < 2; ++n) acc[a][b][m][n] = (f32x4){z0, z0, z0, z0};
    bf16x8 At[4][2], B0[2][2], B1[2][2];
    unsigned cvo[2][2], nvo[2][2], tvo[2][2];
    const char* cA = S.a_tile(cur); const char* cB = S.b_tile(cur);
    S.a_ready(cur);
    if constexpr (GATHER) { const PG8_LAS int* rw = S.a_rows(cur);
#pragma unroll
        for (int h = 0; h < 2; ++h)
#pragma unroll
            for (int i = 0; i < 2; ++i) cvo[h][i] = (unsigned)rw[h * HALF + rA[i]] * (unsigned)(lda * 2) + (unsigned)cA2[i]; }
    PG8_STAGE(PG8_SB(0, 0), cB, voffB); PG8_STAGE(PG8_SB(0, 1), cB + hstep, voffB); PG8_STAGE_A(PG8_SA(0, 0), cA, 0, cvo); PG8_STAGE_A(PG8_SA(0, 1), cA, 1, cvo);
    if (wr == 1) PG8_BAR;
    PG8_WAIT_V(2); PG8_BAR;
    PG8_STAGE(PG8_SB(1, 0), cB + kstep, voffB); PG8_STAGE_A(PG8_SA(1, 0), cA + kstep, 0, cvo); PG8_STAGE(PG8_SB(1, 1), cB + hstep + kstep, voffB);
    PG8_WAIT_V(6); PG8_BAR;
    int ui = 0;
    for (;;) {
        const bool has_next = S.next(ui + 1, nxt);
        const char* nA = has_next ? S.a_tile(nxt) : cA; const char* nB = has_next ? S.b_tile(nxt) : cB;
        if constexpr (GATHER) {
            if (has_next) { const PG8_LAS int* rw = S.a_rows(nxt);
#pragma unroll
                for (int h = 0; h < 2; ++h)
#pragma unroll
                    for (int i = 0; i < 2; ++i) nvo[h][i] = (unsigned)rw[h * HALF + rA[i]] * (unsigned)(lda * 2) + (unsigned)cA2[i]; }
            else {
#pragma unroll
                for (int h = 0; h < 2; ++h)
#pragma unroll
                    for (int i = 0; i < 2; ++i) nvo[h][i] = cvo[h][i]; }
        }
        for (int t = 0; t < nt; t += 2) {
            const bool last = (t == nt - 2);
            const char* a1 = cA + (size_t)(t + 1) * kstep;
            const char* a2 = last ? nA : cA + (size_t)(t + 2) * kstep; const char* b2 = last ? nB : cB + (size_t)(t + 2) * kstep;
            const char* a3 = a2 + kstep; const char* b3 = b2 + kstep;
            if (last && has_next) S.a_ready(nxt);
            if constexpr (GATHER) {
#pragma unroll
                for (int h = 0; h < 2; ++h)
#pragma unroll
                    for (int i = 0; i < 2; ++i) tvo[h][i] = last ? nvo[h][i] : cvo[h][i]; }
            PG8_LDB(B0, 0, 0); PG8_LDB(B1, 0, 1); PG8_SCHED; PG8_LDA(At, 0, 0); PG8_STAGE_A(PG8_SA(1, 1), a1, 1, cvo);
            PG8_WAIT_V(8); PG8_WAIT_L(0); PG8_BAR; PG8_MMA(0, 0, At, B0); PG8_MMA(0, 1, At, B1); PG8_BAR; PG8_SCHED;
            PG8_LDA(At, 0, 1); PG8_STAGE(PG8_SB(0, 0), b2, voffB); PG8_STAGE(PG8_SB(0, 1), b2 + hstep, voffB); PG8_STAGE_A(PG8_SA(0, 0), a2, 0, tvo);
            PG8_WAIT_V(8); PG8_WAIT_L(0); PG8_BAR; PG8_MMA(1, 0, At, B0); PG8_MMA(1, 1, At, B1); PG8_BAR; PG8_SCHED;
            PG8_LDB(B0, 1, 0); PG8_LDB(B1, 1, 1); PG8_SCHED; PG8_LDA(At, 1, 0); PG8_STAGE_A(PG8_SA(0, 1), a2, 1, tvo);
            PG8_WAIT_V(8); PG8_WAIT_L(0); PG8_BAR; PG8_MMA(0, 0, At, B0); PG8_MMA(0, 1, At, B1); PG8_BAR; PG8_SCHED;
            PG8_LDA(At, 1, 1); PG8_STAGE(PG8_SB(1, 0), b3, voffB); PG8_STAGE(PG8_SB(1, 1), b3 + hstep, voffB); PG8_STAGE_A(PG8_SA(1, 0), a3, 0, tvo);
            PG8_WAIT_V(8); PG8_WAIT_L(0); PG8_BAR; PG8_MMA(1, 0, At, B0); PG8_MMA(1, 1, At, B1); PG8_BAR; PG8_SCHED;
        }
        if (wr == 0) PG8_BAR;
        E(acc, cur, wr, wc, fr, fq);
        if (!has_next) break;
#pragma unroll
        for (int a = 0; a < 2; ++a)
#pragma unroll
            for (int b = 0; b < 2; ++b)
#pragma unroll
                for (int m = 0; m < 4; ++m)
#pragma unroll
                    for (int n = 0; n < 2; ++n) acc[a][b][m][n] = (f32x4){z0, z0, z0, z0};
        cur = nxt; cA = nA; cB = nB; ++ui;
        if constexpr (GATHER) {
#pragma unroll
            for (int h = 0; h < 2; ++h)
#pragma unroll
                for (int i = 0; i < 2; ++i) cvo[h][i] = nvo[h][i]; }
        if (wr == 1) PG8_BAR;
    }
    PG8_WAIT_V(0);
    PG8_BAR;
#undef PG8_SA
#undef PG8_SB
#undef PG8_STAGE
#undef PG8_STAGE_A
#undef PG8_LDA
#undef PG8_LDB
#undef PG8_MMA
#undef PG8_WAIT_V
#undef PG8_WAIT_L
#undef PG8_BAR
#undef PG8_SCHED
}
}

constexpr int NWAVES = 8, NTHR = 512;
constexpr int RING_BYTES = 131072, LDS_BYTES = 147456;
constexpr int MISC_OFF = RING_BYTES;

struct Args {
    const float* in[25];
    float* out;
    unsigned char* ws;
    unsigned* ctl;
    bf16* win_t;
    bf16* wout_t;
    float* hres;
    bf16* hb;
    float* rstd;
    bf16* qb; bf16* kb; bf16* vb;
    bf16* ug;
    bf16* hq; bf16* hk; bf16* hv; bf16* hg;
    float* hlogf;
    float* lbt;
    bf16* mixb;
    bf16* wgu_t;
    bf16* wd_t;
    int* tokl;
    float* gl;
    int* sl;
    bf16* hmid;
    bf16* ybuf;
    bf16* s5et;
    bf16* s5mf;
    float* s5a32;
    float* xend;
    bf16* zb;
    bf16* wglu_t;
    bf16* hub;
    float* hdb;
    bf16* hsp;
    bf16* wrh;
    bf16* wrl;
};

struct KArgs { const float* in[25]; float* out; unsigned char* ws; int pi0, nprog; };
constexpr size_t MiBc = (size_t)1 << 20;
constexpr size_t rup(size_t x) { return (x + MiBc - 1) & ~(MiBc - 1); }
constexpr size_t O_CTL = 0;
constexpr size_t O_WIN = O_CTL + rup(MiBc);
constexpr size_t O_WOUT = O_WIN + rup((size_t)DEPTH * INCP * DM * 2);
constexpr size_t O_HRES = O_WOUT + rup((size_t)DEPTH * DM * DM * 2);
constexpr size_t O_HB = O_HRES + rup((size_t)T * DM * 4);
constexpr size_t O_RSTD = O_HB + rup((size_t)T * DM * 2);
constexpr size_t O_QKV = O_RSTD + rup((size_t)T * 4);
constexpr size_t O_UG = O_QKV + rup((size_t)3 * T * AW * 2);
constexpr size_t O_HQ = O_UG + rup((size_t)SG * 256 * S5LD * 2);
constexpr size_t O_HLOGF = O_HQ + rup((size_t)4 * T * HW * 2);
constexpr size_t O_LBT = O_HLOGF + rup((size_t)T * HW * 4);
constexpr size_t O_MIXB = O_LBT + rup((size_t)DEPTH * HW * 2 * 4);
constexpr size_t O_WGU = O_MIXB + rup((size_t)T * DM * 2);
constexpr size_t O_WD = O_WGU + rup((size_t)DEPTH * NE * 1024 * DM * 2);
constexpr size_t O_TOKL = O_WD + rup((size_t)DEPTH * NE * DM * DE * 2);
constexpr size_t O_GL = O_TOKL + rup((size_t)NE * T * 4);
constexpr size_t O_SL = O_GL + rup((size_t)NE * T * 4);
constexpr size_t O_S5ET = O_SL + rup((size_t)T * 2 * 4);
constexpr size_t O_S5MF = O_S5ET + rup((size_t)DEPTH * SG * 256 * 512 * 2);
constexpr size_t O_S5A32 = O_S5MF + rup((size_t)DEPTH * SG * 512 * 640 * 2);
constexpr size_t O_XEND = O_S5A32 + rup((size_t)DEPTH * SG * 64 * 2 * 4);
constexpr size_t O_ZB = O_XEND + rup((size_t)SG * 128 * 256 * 4);
constexpr size_t O_WGLU = O_ZB + rup((size_t)T * SW * 2);
constexpr size_t O_HUB = O_WGLU + rup((size_t)DEPTH * 768 * SW * 2);
constexpr size_t O_HDB = O_HUB + rup((size_t)640 * HD * HD * 2);
constexpr size_t O_HSP = O_HDB + rup((size_t)640 * HD * 4);
constexpr size_t O_WRH = O_HSP + rup((size_t)640 * HD * HD * 2);
constexpr size_t O_WRL = O_WRH + rup((size_t)DEPTH * 64 * DM * 2);
constexpr size_t O_YBUF = O_WRL + rup((size_t)DEPTH * 64 * DM * 2);
constexpr size_t O_HMID = O_YBUF + rup((size_t)96 * 256 * DM * 2);
constexpr size_t O_END = O_HMID + rup((size_t)96 * 256 * DE * 2);
__host__ __device__ __forceinline__ void fill_ws(Args& a, unsigned char* ws) {
    a.ws = ws; a.ctl = (unsigned*)(ws + O_CTL); a.win_t = (bf16*)(ws + O_WIN); a.wout_t = (bf16*)(ws + O_WOUT); a.hres = (float*)(ws + O_HRES); a.hb = (bf16*)(ws + O_HB);
    a.rstd = (float*)(ws + O_RSTD); a.qb = (bf16*)(ws + O_QKV); a.kb = a.qb + (size_t)T * AW; a.vb = a.kb + (size_t)T * AW; a.ug = (bf16*)(ws + O_UG);
    a.hq = (bf16*)(ws + O_HQ); a.hk = a.hq + (size_t)T * HW; a.hv = a.hk + (size_t)T * HW; a.hg = a.hv + (size_t)T * HW; a.hlogf = (float*)(ws + O_HLOGF);
    a.lbt = (float*)(ws + O_LBT); a.mixb = (bf16*)(ws + O_MIXB); a.wgu_t = (bf16*)(ws + O_WGU); a.wd_t = (bf16*)(ws + O_WD); a.tokl = (int*)(ws + O_TOKL);
    a.gl = (float*)(ws + O_GL); a.sl = (int*)(ws + O_SL); a.s5et = (bf16*)(ws + O_S5ET); a.s5mf = (bf16*)(ws + O_S5MF); a.s5a32 = (float*)(ws + O_S5A32);
    a.xend = (float*)(ws + O_XEND); a.zb = (bf16*)(ws + O_ZB); a.wglu_t = (bf16*)(ws + O_WGLU); a.hub = (bf16*)(ws + O_HUB); a.hdb = (float*)(ws + O_HDB);
    a.hsp = (bf16*)(ws + O_HSP); a.wrh = (bf16*)(ws + O_WRH); a.wrl = (bf16*)(ws + O_WRL); a.ybuf = (bf16*)(ws + O_YBUF); a.hmid = (bf16*)(ws + O_HMID);
}

struct TrItem { const float* src; const float* ks; bf16* dst; int N, K; };
template <bool SC>
__device__ __forceinline__ void tr_load(const TrItem& t, f32x4 (&v)[8], float (&sc)[8], int lane) {
    const int kr = lane >> 3, n4 = lane & 7;
#pragma unroll
    for (int i = 0; i < 8; ++i) v[i] = __builtin_nontemporal_load((const GAS f32x4*)(t.src + (size_t)(8 * i + kr) * t.N + 4 * n4));
    if constexpr (SC) {
#pragma unroll
        for (int i = 0; i < 8; ++i) sc[i] = *(const GAS float*)(t.ks + 8 * i + kr);
    }
}
template <bool SC>
__device__ __forceinline__ void tr_finish(const TrItem& t, f32x4 (&v)[8], float (&sc)[8], LAS float* scr, int lane) {
    const int kr = lane >> 3, n4 = lane & 7;
#pragma unroll
    for (int i = 0; i < 8; ++i) { const int kk = 8 * i + kr; f32x4 x = v[i]; if constexpr (SC) x = x * sc[i];
        LAS float* d = scr + kk * 33 + 4 * n4; d[0] = x[0]; d[1] = x[1]; d[2] = x[2]; d[3] = x[3]; }
    LDS_WAIT(); asm volatile("" ::: "memory");
    const int c = lane & 7;
#pragma unroll
    for (int j = 0; j < 4; ++j) { const int n = (lane >> 3) + 8 * j; const LAS float* sp = scr + (8 * c) * 33 + n;
        v4u o; o.x = pk2(sp[0 * 33], sp[1 * 33]); o.y = pk2(sp[2 * 33], sp[3 * 33]); o.z = pk2(sp[4 * 33], sp[5 * 33]); o.w = pk2(sp[6 * 33], sp[7 * 33]);
        __builtin_nontemporal_store(o, (GAS v4u*)(t.dst + (size_t)n * t.K + 8 * c)); }
    LDS_WAIT(); asm volatile("" ::: "memory");
}
template <bool SC, class F>
__device__ __forceinline__ void tr_loop(const F& mk, int nitems, int gw, int NGW, LAS float* scr, int lane) {
    if (gw >= nitems) return;
    const int nit = (nitems - gw + NGW - 1) / NGW, last = nit - 1;
    TrItem c0 = mk(gw), c1 = mk(gw + (1 < last ? 1 : last) * NGW), c2 = c0; f32x4 v0[8], v1[8], v2[8]; float s0[8], s1[8], s2[8];
    tr_load<SC>(c0, v0, s0, lane);
    tr_load<SC>(c1, v1, s1, lane);
    for (int i = 0; ; i += 3) {
        c2 = mk(gw + (i + 2 < last ? i + 2 : last) * NGW); tr_load<SC>(c2, v2, s2, lane);
        tr_finish<SC>(c0, v0, s0, scr, lane);
        if (i + 1 >= nit) break;
        c0 = mk(gw + (i + 3 < last ? i + 3 : last) * NGW); tr_load<SC>(c0, v0, s0, lane);
        tr_finish<SC>(c1, v1, s1, scr, lane);
        if (i + 2 >= nit) break;
        c1 = mk(gw + (i + 4 < last ? i + 4 : last) * NGW); tr_load<SC>(c1, v1, s1, lane);
        tr_finish<SC>(c2, v2, s2, scr, lane);
        if (i + 3 >= nit) break;
    }
}
struct MkIn {
    const float* win; const float* g; bf16* win_t; int off;
    __device__ __forceinline__ TrItem operator()(int it0) const {
        constexpr int I_IN = (DM / 64) * (INC / 32);
        const int it = it0 + off, ll = it / I_IN, r = it % I_IN, kb = r / (INC / 32), nb = r % (INC / 32), k0 = 64 * kb, n0 = 32 * nb; TrItem t;
        t.src = win + (size_t)ll * DM * INC + (size_t)k0 * INC + n0; t.ks = g + ll * DM + k0; t.dst = win_t + (size_t)ll * INCP * DM + (size_t)n0 * DM + k0; t.N = INC; t.K = DM;
        return t; }
};
struct MkOut {
    const float* wout; bf16* wout_t; int off;
    __device__ __forceinline__ TrItem operator()(int it0) const {
        constexpr int I_OUT = (DM / 64) * (DM / 32);
        const int it = it0 + off, ll = it / I_OUT, q = it % I_OUT, kb = q / (DM / 32), nb = q % (DM / 32), k0 = 64 * kb, n0 = 32 * nb; TrItem t;
        t.src = wout + (size_t)ll * DM * DM + (size_t)k0 * DM + n0; t.ks = nullptr; t.dst = wout_t + (size_t)ll * DM * DM + (size_t)n0 * DM + k0; t.N = DM; t.K = DM;
        return t; }
};
struct MkGlu {
    const float* w; bf16* wt;
    __device__ __forceinline__ TrItem operator()(int it) const {
        constexpr int I_GL = (SW / 64) * (SW / 32);
        const int ll = it / I_GL, r = it % I_GL, kb = r / (SW / 32), nb = r % (SW / 32), k0 = 64 * kb, n0 = 32 * nb; TrItem t;
        t.src = w + (size_t)ll * SW * SW + (size_t)k0 * SW + n0; t.ks = nullptr; t.dst = wt + (size_t)ll * 768 * SW + (size_t)n0 * SW + k0; t.N = SW; t.K = SW; return t; }
};
struct MkMoeGU {
    const float* wg; const float* wu; const float* g; bf16* wgu_t; int off;
    __device__ __forceinline__ TrItem operator()(int it0) const {
        constexpr int I_G = (DM / 64) * (DE / 32);
        const int it = off < 0 ? (-off - 1 - it0) : it0 + off, le = it / (2 * I_G), r = it % (2 * I_G), ll = le / NE; TrItem t;
        const int up = r / I_G, q = r % I_G, kb = q / (DE / 32), nb = q % (DE / 32), k0 = 64 * kb, n0 = 32 * nb;
        const int d0 = (n0 >> 7) * 256 + up * 128 + (n0 & 127);
        t.src = (up ? wu : wg) + (size_t)le * DM * DE + (size_t)k0 * DE + n0; t.ks = g + ll * DM + k0; t.dst = wgu_t + (size_t)le * 1024 * DM + (size_t)d0 * DM + k0; t.N = DE; t.K = DM;
        return t; }
};
struct MkMoeD {
    const float* wd; bf16* wd_t; int off;
    __device__ __forceinline__ TrItem operator()(int it0) const {
        constexpr int I_D = (DE / 64) * (DM / 32);
        const int it = off < 0 ? (-off - 1 - it0) : it0 + off, le = it / I_D, q = it % I_D, kb = q / (DM / 32), nb = q % (DM / 32), k0 = 64 * kb, n0 = 32 * nb; TrItem t;
        t.src = wd + (size_t)le * DE * DM + (size_t)k0 * DM + n0; t.ks = nullptr; t.dst = wd_t + (size_t)le * DM * DE + (size_t)n0 * DE + k0; t.N = DM; t.K = DE;
        return t; }
};
__device__ __forceinline__ void stats_row(const float* xrow, bf16* orow, float* rstd_out, int lane) {
    const GAS f32x4* xr = (const GAS f32x4*)xrow + lane;
    f32x4 v[8]; float s = 0.f;
#pragma unroll
    for (int j = 0; j < 8; ++j) { v[j] = xr[64 * j]; s += (v[j].x * v[j].x + v[j].y * v[j].y) + (v[j].z * v[j].z + v[j].w * v[j].w); }
    s = wave_sum(s);
    if (lane == 0) *rstd_out = 1.0f / sqrtf(s * (1.f / DM) + EPS);
    GAS v2u* o8 = (GAS v2u*)orow + lane;
#pragma unroll
    for (int j = 0; j < 8; ++j) { v2u w; w.x = pk2(v[j].x, v[j].y); w.y = pk2(v[j].z, v[j].w); o8[64 * j] = w; }
}

struct EpiProj {
    static constexpr bool PERM = true;
    const float* rstd; bf16 *qb, *kb, *vb, *ug, *hq, *hk, *hv, *hg; float* hlogf; const float* lbt;
    template <int bj>
    __device__ __forceinline__ void half(const f32x4 (&acc)[2][2][4][2], const float (&rs)[2][4], int hc, int row0, int cin) const {
        if (hc >= 43) return;
        if (hc < 18) {
            bf16* base = qb + (size_t)(hc / 6) * ((size_t)T * AW); const int c0 = (hc % 6) * 128 + cin;
#pragma unroll
            for (int ai = 0; ai < 2; ++ai)
#pragma unroll
                for (int m = 0; m < 4; ++m) { const int row = row0 + ai * 128 + m * 16; const float r = rs[ai][m];
                    const f32x4 a = acc[ai][bj][m][0] * r, b = acc[ai][bj][m][1] * r;
                    v4u w; w.x = cvt_pk_bf16(a[0], a[1]); w.y = cvt_pk_bf16(a[2], a[3]); w.z = cvt_pk_bf16(b[0], b[1]); w.w = cvt_pk_bf16(b[2], b[3]);
                    *(v4u*)(base + (size_t)row * AW + c0) = w; }
        } else if (hc < 23) {
            const int ch = (hc - 18) * 128 + cin, g = ch >> 4, c = ch & 15;
#pragma unroll
            for (int ai = 0; ai < 2; ++ai)
#pragma unroll
                for (int m = 0; m < 4; ++m) { const int row = row0 + ai * 128 + m * 16; const float r = rs[ai][m];
                    const f32x4 a = acc[ai][bj][m][0] * r, b = acc[ai][bj][m][1] * r;
                    v4u w; w.x = cvt_pk_bf16(a[0], a[1]); w.y = cvt_pk_bf16(a[2], a[3]); w.z = cvt_pk_bf16(b[0], b[1]); w.w = cvt_pk_bf16(b[2], b[3]);
                    *(v4u*)(ug + ((size_t)g * 256 + (row >> 5)) * S5LD + (row & 31) * SC + c) = w; }
        } else {
            const int kind = (hc - 23) / 5, ch = ((hc - 23) % 5) * 128 + cin;
            if (kind == 1) {
                float lbv[8], omv[8];
#pragma unroll
                for (int j = 0; j < 8; ++j) { lbv[j] = lbt[(ch + j) * 2]; omv[j] = lbt[(ch + j) * 2 + 1]; }
#pragma unroll
                for (int ai = 0; ai < 2; ++ai)
#pragma unroll
                    for (int m = 0; m < 4; ++m) { const int row = row0 + ai * 128 + m * 16; const float r = rs[ai][m];
                        const f32x4 a = acc[ai][bj][m][0] * r, b = acc[ai][bj][m][1] * r;
                        const float v[8] = {a[0], a[1], a[2], a[3], b[0], b[1], b[2], b[3]};
                        float lf[8], kk[8];
#pragma unroll
                        for (int j = 0; j < 8; ++j) {
                            const float x = fmaxf(v[j], -80.f), e = __builtin_amdgcn_exp2f(-1.4426950408889634f * x), sg = __builtin_amdgcn_rcpf(1.f + e);
                            lf[j] = __builtin_amdgcn_logf(fmaf(omv[j], sg, lbv[j])) * 0.6931471805599453f; kk[j] = omv[j] * e * sg; }
                        *(f32x4*)(hlogf + (size_t)row * HW + ch) = (f32x4){lf[0], lf[1], lf[2], lf[3]};
                        *(f32x4*)(hlogf + (size_t)row * HW + ch + 4) = (f32x4){lf[4], lf[5], lf[6], lf[7]};
                        v4u w; w.x = cvt_pk_bf16(kk[0], kk[1]); w.y = cvt_pk_bf16(kk[2], kk[3]); w.z = cvt_pk_bf16(kk[4], kk[5]); w.w = cvt_pk_bf16(kk[6], kk[7]);
                        *(v4u*)(hk + (size_t)row * HW + ch) = w; }
            } else {
                bf16* base = hq + (size_t)kind * ((size_t)T * HW);
#pragma unroll
                for (int ai = 0; ai < 2; ++ai)
#pragma unroll
                    for (int m = 0; m < 4; ++m) { const int row = row0 + ai * 128 + m * 16; const float r = rs[ai][m];
                        const f32x4 a = acc[ai][bj][m][0] * r, b = acc[ai][bj][m][1] * r;
                        float v[8] = {a[0], a[1], a[2], a[3], b[0], b[1], b[2], b[3]};
                        if (kind == 0) {
#pragma unroll
                            for (int j = 0; j < 8; ++j) v[j] = v[j] * sigmoidf_(v[j]) * 0.08838834764831845f;
                        } else if (kind == 3) {
#pragma unroll
                            for (int j = 0; j < 8; ++j) v[j] = sigmoidf_(v[j]);
                        }
                        v4u w; w.x = cvt_pk_bf16(v[0], v[1]); w.y = cvt_pk_bf16(v[2], v[3]); w.z = cvt_pk_bf16(v[4], v[5]); w.w = cvt_pk_bf16(v[6], v[7]);
                        *(v4u*)(base + (size_t)row * HW + ch) = w; }
            }
        }
    }
    __device__ __forceinline__ void operator()(const f32x4 (&acc)[2][2][4][2], const pg8::Unit& u, int wr, int wc, int fr, int fq) const {
        const int row0 = u.pm * 256 + wr * 64 + fr, cin = wc * 32 + 8 * fq;
        float rs[2][4];
#pragma unroll
        for (int ai = 0; ai < 2; ++ai)
#pragma unroll
            for (int m = 0; m < 4; ++m) rs[ai][m] = rstd[row0 + ai * 128 + m * 16];
        half<0>(acc, rs, 2 * u.pn, row0, cin);
        half<1>(acc, rs, 2 * u.pn + 1, row0, cin);
    }
};
struct EpiResid {
    static constexpr bool PERM = true;
    bf16* hb; unsigned* ready;
    __device__ __forceinline__ void operator()(const f32x4 (&acc)[2][2][4][2], const pg8::Unit& u, int wr, int wc, int fr, int fq) const {
        const int row0 = u.pm * 256 + wr * 64 + fr, col0 = u.pn * 256 + wc * 32 + 8 * fq;
#pragma unroll
        for (int ai = 0; ai < 2; ++ai)
#pragma unroll
            for (int m = 0; m < 4; ++m) { bf16* rp = hb + (size_t)(row0 + ai * 128 + m * 16) * DM + col0;
#pragma unroll
                for (int bj = 0; bj < 2; ++bj) { const v4u r = *(const v4u*)(rp + bj * 128); const f32x4 a = acc[ai][bj][m][0], b = acc[ai][bj][m][1];
                    v4u w;
                    w.x = cvt_pk_bf16(__builtin_bit_cast(float, r.x << 16) + a[0], __builtin_bit_cast(float, r.x & 0xffff0000u) + a[1]);
                    w.y = cvt_pk_bf16(__builtin_bit_cast(float, r.y << 16) + a[2], __builtin_bit_cast(float, r.y & 0xffff0000u) + a[3]);
                    w.z = cvt_pk_bf16(__builtin_bit_cast(float, r.z << 16) + b[0], __builtin_bit_cast(float, r.z & 0xffff0000u) + b[1]);
                    w.w = cvt_pk_bf16(__builtin_bit_cast(float, r.w << 16) + b[2], __builtin_bit_cast(float, r.w & 0xffff0000u) + b[3]);
                    bf16* dp = rp + bj * 128;
                    asm volatile("global_store_dwordx4 %0, %1, off sc1\n\ts_nop 1" :: "v"(dp), "v"(w) : "memory"); } }
        asm volatile("s_waitcnt vmcnt(0)" ::: "memory");
        if ((fr | fq) == 0) __hip_atomic_fetch_add(ready + 16 * u.pm, 1u, __ATOMIC_RELAXED, __HIP_MEMORY_SCOPE_AGENT);
    }
};

__device__ __forceinline__ unsigned xb_ld(unsigned* p);
#define XB_SPIN_CAP (1u << 18)
constexpr int CONV_S = 8192;
constexpr int MAXTILES = 96, MAXROWS = MAXTILES * 256, MAXUNITS = 8;
__device__ __forceinline__ int moe_rank(int bx, int lo, int G) {
    if (bx < lo) return -1;
    const int n = G - lo;
    if ((n & 7) || (lo & 7)) return bx - lo;
    return (bx & 7) * (n >> 3) + ((bx - lo) >> 3);
}
struct MoeOrder {
    const bf16* A; const bf16* Bt; int K, lda;
    size_t estride; int NP, G, c; bool gather;
    const LAS int* tpre; const LAS int* rowsl;
    unsigned* ready; unsigned need; unsigned* tmo;
    __device__ __forceinline__ bool next(int i, pg8::Unit& u) const {
        if (c < 0 || i >= MAXUNITS) return false;
        const int L = i * G + c; if (L >= tpre[NE] * NP) return false;
        int e = 0; while (tpre[e + 1] * NP <= L) ++e;
        const int r = L - tpre[e] * NP, mte = tpre[e + 1] - tpre[e];
        u.e = e; u.pn = r / mte; u.pm = tpre[e] + r % mte; u.li = i; return true;
    }
    __device__ __forceinline__ const char* a_tile(const pg8::Unit& u) const { return gather ? (const char*)A : (const char*)A + (size_t)u.pm * 256 * K * 2; }
    __device__ __forceinline__ const char* b_tile(const pg8::Unit& u) const { return (const char*)Bt + ((size_t)u.e * estride + (size_t)u.pn * 256 * K) * 2; }
    __device__ __forceinline__ const LAS int* a_rows(const pg8::Unit& u) const { return rowsl + u.li * 256; }
    __device__ __forceinline__ void a_ready(const pg8::Unit& u) const {
        if (ready == nullptr) return;
        if (tidx() < 64) {
            unsigned sp = 0;
            while ((unsigned)__builtin_amdgcn_readfirstlane(__hip_atomic_load(ready + 16 * u.pm, __ATOMIC_RELAXED, __HIP_MEMORY_SCOPE_AGENT)) < need) {
                __builtin_amdgcn_s_sleep(2);
                if ((++sp & 255u) == 0u) { if (xb_ld(tmo)) break; if (sp > XB_SPIN_CAP) { if (tidx() == 0) atomicAdd(tmo, 1u); break; } } }
            __builtin_amdgcn_fence(__ATOMIC_ACQUIRE, "agent");
            asm volatile("s_waitcnt vmcnt(0)" ::: "memory");
        }
        asm volatile("" ::: "memory"); __builtin_amdgcn_s_barrier(); asm volatile("" ::: "memory");
    }
};
struct EpiGU {
    static constexpr bool PERM = true;
    const float* rstd; bf16* hmid; const LAS int* rowsl; unsigned* ready;
    __device__ __forceinline__ void operator()(const f32x4 (&acc)[2][2][4][2], const pg8::Unit& u, int wr, int wc, int fr, int fq) const {
        const int rl0 = wr * 64 + fr, c0 = u.pn * 128 + wc * 32 + 8 * fq;
        float rsv[2][4];
#pragma unroll
        for (int ai = 0; ai < 2; ++ai)
#pragma unroll
            for (int m = 0; m < 4; ++m) rsv[ai][m] = rstd[rowsl[u.li * 256 + rl0 + ai * 128 + m * 16]];
#pragma unroll
        for (int ai = 0; ai < 2; ++ai)
#pragma unroll
            for (int m = 0; m < 4; ++m) { const int rl = rl0 + ai * 128 + m * 16; const float r = rsv[ai][m];
                const f32x4 g0 = acc[ai][0][m][0] * r, g1 = acc[ai][0][m][1] * r, u0 = acc[ai][1][m][0] * r, u1 = acc[ai][1][m][1] * r;
                float v[8];
#pragma unroll
                for (int j = 0; j < 4; ++j) { v[j] = g0[j] * sigmoidf_(g0[j]) * u0[j]; v[4 + j] = g1[j] * sigmoidf_(g1[j]) * u1[j]; }
                v4u w; w.x = cvt_pk_bf16(v[0], v[1]); w.y = cvt_pk_bf16(v[2], v[3]); w.z = cvt_pk_bf16(v[4], v[5]); w.w = cvt_pk_bf16(v[6], v[7]);
                bf16* dst = hmid + (size_t)(u.pm * 256 + rl) * DE + c0;
                asm volatile("global_store_dwordx4 %0, %1, off sc1\n\ts_nop 1" :: "v"(dst), "v"(w) : "memory"); }
        asm volatile("s_waitcnt vmcnt(0)" ::: "memory");
        if (ready && (fr | fq) == 0) __hip_atomic_fetch_add(ready + 16 * u.pm, 1u, __ATOMIC_RELAXED, __HIP_MEMORY_SCOPE_AGENT);
    }
};
struct EpiDown {
    static constexpr bool PERM = true;
    const float* gl; const int* cnt; bf16* ybuf; const LAS int* tpre;
    __device__ __forceinline__ void operator()(const f32x4 (&acc)[2][2][4][2], const pg8::Unit& u, int wr, int wc, int fr, int fq) const {
        const int rl0 = wr * 64 + fr, col0 = u.pn * 256 + wc * 32 + 8 * fq;
        const int pos0 = (u.pm - tpre[u.e]) * 256, ce = tpre[64 + u.e];
        float gtv[2][4];
#pragma unroll
        for (int ai = 0; ai < 2; ++ai)
#pragma unroll
            for (int m = 0; m < 4; ++m) { const int pos = pos0 + rl0 + ai * 128 + m * 16; gtv[ai][m] = gl[(size_t)u.e * T + (pos < ce ? pos : 0)]; }
#pragma unroll
        for (int ai = 0; ai < 2; ++ai)
#pragma unroll
            for (int m = 0; m < 4; ++m) { const int rl = rl0 + ai * 128 + m * 16, pos = pos0 + rl;
                if (pos < ce) { const float gt = gtv[ai][m]; bf16* yr = ybuf + (size_t)(u.pm * 256 + rl) * DM + col0;
#pragma unroll
                    for (int bj = 0; bj < 2; ++bj) { const f32x4 v0 = acc[ai][bj][m][0] * gt, v1 = acc[ai][bj][m][1] * gt;
                        v4u w; w.x = cvt_pk_bf16(v0[0], v0[1]); w.y = cvt_pk_bf16(v0[2], v0[3]); w.z = cvt_pk_bf16(v1[0], v1[1]); w.w = cvt_pk_bf16(v1[2], v1[3]);
                        *(v4u*)(yr + bj * 128) = w; } } }
    }
};
__device__ __forceinline__ void moe_tiles(const int* cnt, LAS int* tpre, int tid) {
    if (tid < NE) tpre[64 + tid] = cnt[tid * 64];
    __syncthreads();
    if (tid == 0) { int s = 0; for (int e = 0; e < NE; ++e) { tpre[e] = s; s += (tpre[64 + e] + 255) >> 8; } tpre[NE] = s; }
    __syncthreads();
}

struct S5Order {
    const bf16* A; const bf16* Bt; int K, lda;
    size_t gstrideB; int NP, G, c;
    __device__ __forceinline__ bool next(int i, pg8::Unit& u) const {
        const int L = i * G + c; if (L >= SG * NP) return false;
        u.e = L / NP; u.pn = L % NP; u.pm = 0; u.li = i; return true;
    }
    __device__ __forceinline__ const char* a_tile(const pg8::Unit& u) const { return (const char*)A + (size_t)u.e * 256 * S5LD * 2; }
    __device__ __forceinline__ const char* b_tile(const pg8::Unit& u) const { return (const char*)Bt + ((size_t)u.e * gstrideB + (size_t)u.pn * 256 * K) * 2; }
    __device__ __forceinline__ const LAS int* a_rows(const pg8::Unit&) const { return nullptr; }
    __device__ __forceinline__ void a_ready(const pg8::Unit&) const {}
};
struct EpiS5A {
    static constexpr bool PERM = false;
    float* xend;
    __device__ __forceinline__ void operator()(const f32x4 (&acc)[2][2][4][2], const pg8::Unit& u, int wr, int wc, int fr, int fq) const {
        const int row0 = wr * 64 + fr, col0 = wc * 32 + 4 * fq;
        float* base = xend + (size_t)u.e * 128 * 256;
#pragma unroll
        for (int ai = 0; ai < 2; ++ai)
#pragma unroll
            for (int m = 0; m < 4; ++m) { const int row = row0 + ai * 128 + m * 16;
#pragma unroll
                for (int n = 0; n < 2; ++n) { const f32x4 v = acc[ai][0][m][n];
#pragma unroll
                    for (int j = 0; j < 4; ++j) base[(size_t)(col0 + n * 16 + j) * 256 + row] = v[j]; } }
    }
};
struct EpiS5C {
    static constexpr bool PERM = true;
    bf16* zb;
    __device__ __forceinline__ void operator()(const f32x4 (&acc)[2][2][4][2], const pg8::Unit& u, int wr, int wc, int fr, int fq) const {
        const int row0 = wr * 64 + fr;
#pragma unroll
        for (int bj = 0; bj < 2; ++bj) { const int col = u.pn * 256 + bj * 128 + wc * 32 + 8 * fq, t = col >> 4, c = col & 15;
#pragma unroll
            for (int ai = 0; ai < 2; ++ai)
#pragma unroll
                for (int m = 0; m < 4; ++m) { const int row = row0 + ai * 128 + m * 16;
                    const f32x4 a = acc[ai][bj][m][0], b = acc[ai][bj][m][1];
                    float v[8] = {a[0], a[1], a[2], a[3], b[0], b[1], b[2], b[3]};
#pragma unroll
                    for (int j = 0; j < 8; ++j) { const float x = v[j], w = 0.7978845608028654f * (x + 0.044715f * x * x * x); v[j] = x * __builtin_amdgcn_rcpf(1.f + __builtin_amdgcn_exp2f(-2.8853900817779268f * w)); }
                    v4u w; w.x = cvt_pk_bf16(v[0], v[1]); w.y = cvt_pk_bf16(v[2], v[3]); w.z = cvt_pk_bf16(v[4], v[5]); w.w = cvt_pk_bf16(v[6], v[7]);
                    *(v4u*)(zb + ((size_t)row * 32 + t) * SW + u.e * 16 + c) = w; } }
    }
};
struct EpiGLU {
    static constexpr bool PERM = true;
    const bf16* zb; bf16* mixb;
    __device__ __forceinline__ void operator()(const f32x4 (&acc)[2][2][4][2], const pg8::Unit& u, int wr, int wc, int fr, int fq) const {
        const int row0 = u.pm * 256 + wr * 64 + fr;
#pragma unroll
        for (int bj = 0; bj < 2; ++bj) { const int col = u.pn * 256 + bj * 128 + wc * 32 + 8 * fq;
            if (col < SW) {
#pragma unroll
                for (int ai = 0; ai < 2; ++ai)
#pragma unroll
                    for (int m = 0; m < 4; ++m) { const int row = row0 + ai * 128 + m * 16;
                        const v4u zz = *(const v4u*)(zb + (size_t)row * SW + col);
                        const f32x4 a = acc[ai][bj][m][0], b = acc[ai][bj][m][1];
                        const float g[8] = {a[0], a[1], a[2], a[3], b[0], b[1], b[2], b[3]};
                        const unsigned zu[4] = {zz.x, zz.y, zz.z, zz.w};
                        float v[8];
#pragma unroll
                        for (int j = 0; j < 4; ++j) { v[2 * j] = __builtin_bit_cast(float, zu[j] << 16) * sigmoidf_(g[2 * j]); v[2 * j + 1] = __builtin_bit_cast(float, zu[j] & 0xffff0000u) * sigmoidf_(g[2 * j + 1]); }
                        v4u w; w.x = cvt_pk_bf16(v[0], v[1]); w.y = cvt_pk_bf16(v[2], v[3]); w.z = cvt_pk_bf16(v[4], v[5]); w.w = cvt_pk_bf16(v[6], v[7]);
                        *(v4u*)(mixb + (size_t)row * DM + AW + col) = w; } } }
    }
};
__device__ __forceinline__ void s5_tables(const Args& a, int ll, int g, LAS float* L, int tid) {
    LAS float* P = L; LAS float* Bb = L + 33 * 128; LAS float* Cc = Bb + 2048; LAS float* Kj = Cc + 2048;
    const float* a_re = a.in[8] + (size_t)(ll * SG + g) * SN; const float* a_im = a.in[9] + (size_t)(ll * SG + g) * SN;
    const float dt = expf(a.in[10][ll * SG + g]);
    const float* b_re = a.in[11] + (size_t)(ll * SG + g) * SN * SC; const float* b_im = a.in[12] + (size_t)(ll * SG + g) * SN * SC;
    const float* c_re = a.in[13] + (size_t)(ll * SG + g) * SC * SN; const float* c_im = a.in[14] + (size_t)(ll * SG + g) * SC * SN;
    const float* dsk = a.in[15] + ll * SW + g * SC;
    __syncthreads();
    for (int i = tid; i < 33 * 64; i += NTHR) { const int j = i >> 6, n = i & 63;
        const float lr = fminf(a_re[n], -1e-4f), li = a_im[n];
        const float mag = expf(lr * dt * (float)j), ang = li * dt * (float)j;
        P[i * 2] = mag * cosf(ang); P[i * 2 + 1] = mag * sinf(ang); }
    for (int i = tid; i < 64 * 16; i += NTHR) { const int n = i >> 4;
        const float lr = fminf(a_re[n], -1e-4f), li = a_im[n];
        const float mag = expf(lr * dt), abr = mag * cosf(li * dt), abi = mag * sinf(li * dt);
        const float den = lr * lr + li * li, nr = abr - 1.f, ni = abi;
        const float fre = (nr * lr + ni * li) / den, fim = (ni * lr - nr * li) / den;
        const float br = b_re[i], bi = b_im[i];
        Bb[i * 2] = fre * br - fim * bi; Bb[i * 2 + 1] = fre * bi + fim * br; }
    for (int i = tid; i < 16 * 64; i += NTHR) { Cc[i * 2] = c_re[i]; Cc[i * 2 + 1] = c_im[i]; }
    __syncthreads();
    if (tid < 64) { a.s5a32[((size_t)(ll * SG + g) * 64 + tid) * 2] = P[(32 * 64 + tid) * 2]; a.s5a32[((size_t)(ll * SG + g) * 64 + tid) * 2 + 1] = P[(32 * 64 + tid) * 2 + 1]; }
    for (int i = tid; i < 32 * 256; i += NTHR) { const int j = i >> 8, c = (i >> 4) & 15, cp = i & 15; float s = 0.f;
        for (int n = 0; n < 64; ++n) { const float cr = Cc[(c * 64 + n) * 2], ci = Cc[(c * 64 + n) * 2 + 1], pr = P[(j * 64 + n) * 2], pi = P[(j * 64 + n) * 2 + 1];
            const float wr_ = cr * pr - ci * pi, wi_ = cr * pi + ci * pr; s += wr_ * Bb[(n * 16 + cp) * 2] - wi_ * Bb[(n * 16 + cp) * 2 + 1]; }
        if (j == 0 && c == cp) s += dsk[c];
        Kj[i] = s; }
    __syncthreads();
    bf16* et = a.s5et + (size_t)(ll * SG + g) * 256 * 512;
    for (int i = tid; i < 256 * 64; i += NTHR) { const int row = i >> 6, c8 = (i & 63) * 8; unsigned w[4] = {0u, 0u, 0u, 0u};
        if (row < 128) { const int part = row >> 6, n = row & 63, sidx = c8 >> 4, c0 = c8 & 15; float v[8];
            const float pr = P[((31 - sidx) * 64 + n) * 2], pi = P[((31 - sidx) * 64 + n) * 2 + 1];
#pragma unroll
            for (int j = 0; j < 8; ++j) { const float br = Bb[(n * 16 + c0 + j) * 2], bi = Bb[(n * 16 + c0 + j) * 2 + 1]; v[j] = part ? (pr * bi + pi * br) : (pr * br - pi * bi); }
#pragma unroll
            for (int j = 0; j < 4; ++j) w[j] = pk2(v[2 * j], v[2 * j + 1]); }
        *(v4u*)(et + (size_t)row * 512 + c8) = (v4u){w[0], w[1], w[2], w[3]}; }
    bf16* mf = a.s5mf + (size_t)(ll * SG + g) * 512 * 640;
    for (int i = tid; i < 512 * 80; i += NTHR) { const int row = i / 80, c8 = (i % 80) * 8, t = row >> 4, c = row & 15; float v[8];
        if (c8 < 512) { const int sidx = c8 >> 4, c0 = c8 & 15;
#pragma unroll
            for (int j = 0; j < 8; ++j) v[j] = sidx <= t ? Kj[((t - sidx) * 16 + c) * 16 + c0 + j] : 0.f;
        } else { const int part = (c8 - 512) >> 6, n0 = (c8 - 512) & 63;
#pragma unroll
            for (int j = 0; j < 8; ++j) { const int n = n0 + j; const float cr = Cc[(c * 64 + n) * 2], ci = Cc[(c * 64 + n) * 2 + 1], pr = P[((t + 1) * 64 + n) * 2], pi = P[((t + 1) * 64 + n) * 2 + 1];
                v[j] = part ? -(cr * pi + ci * pr) : (cr * pr - ci * pi); } }
        *(v4u*)(mf + (size_t)row * 640 + c8) = (v4u){pk2(v[0], v[1]), pk2(v[2], v[3]), pk2(v[4], v[5]), pk2(v[6], v[7])}; }
    __syncthreads();
}
struct NoSide { __device__ __forceinline__ void operator()(int) const {} };
template <class SIDE = NoSide>
__device__ __forceinline__ void s5_scan_unit(const Args& a, int l, int b, int g, LAS float* L, int tid, const SIDE& side = SIDE()) {
    LAS float* X = L;
    __syncthreads();
    const float* src = a.xend + (size_t)g * 128 * 256 + b * 128;
    for (int i = tid; i < 128 * 128; i += NTHR) { const int p = i >> 7, k = i & 127; X[p * 129 + k] = src[(size_t)p * 256 + k]; }
    __syncthreads();
    if (tid < 64) { const int n = tid; const float ar = a.s5a32[((size_t)(l * SG + g) * 64 + n) * 2], ai = a.s5a32[((size_t)(l * SG + g) * 64 + n) * 2 + 1];
        float xr = 0.f, xi = 0.f;
#pragma unroll 16
        for (int k = 0; k < 128; ++k) { const float er = X[n * 129 + k], ei = X[(64 + n) * 129 + k];
            X[n * 129 + k] = xr; X[(64 + n) * 129 + k] = xi;
            const float nr = ar * xr - ai * xi + er, ni = ar * xi + ai * xr + ei; xr = nr; xi = ni; } }
    else side(tid - 64);
    __syncthreads();
    bf16* dst = a.ug + ((size_t)g * 256 + b * 128) * S5LD + 512;
    for (int i = tid; i < 128 * 64; i += NTHR) { const int k = i >> 6, p2 = (i & 63) * 2;
        *(unsigned*)(dst + (size_t)k * S5LD + p2) = pk2(X[p2 * 129 + k], X[(p2 + 1) * 129 + k]); }
}

namespace hg {
typedef short s16x4 __attribute__((ext_vector_type(4)));
typedef float f32x16 __attribute__((ext_vector_type(16)));
typedef unsigned u32x4 __attribute__((ext_vector_type(4)));
constexpr int CH = 64, NCH = SEQ / CH, NUN = BATCH * HH * NCH;
#define HKSWZ(row, colB) ((row) * 256 + ((colB) ^ (((row) & 7) << 4)))
template <bool SWAP> __device__ __forceinline__ int vst(int k, int c) { const int kk = SWAP ? ((k & ~0xC) | ((k & 4) << 1) | ((k & 8) >> 1)) : k; return ((kk >> 3) * 4 + (c >> 5)) * 512 + ((kk & 7) * 32 + (c & 31)) * 2; }
__device__ __forceinline__ int v_rd_base(int lane) { return ((lane & 3) << 3) | (((lane >> 2) & 3) << 6) | (((lane >> 4) & 1) << 5) | (((lane >> 5) & 1) << 8); }
#define HTRRD(dst, off) asm volatile("ds_read_b64_tr_b16 %0, %1 offset:%2" : "=&v"(dst) : "v"(vb0), "i"(off) : "memory")
#define HFRAG(out, TOFF, cb, ks) do { s16x4 l_, h_; HTRRD(l_, (TOFF) + (cb) * 512 + (ks) * 4096); HTRRD(h_, (TOFF) + (cb) * 512 + (ks) * 4096 + 2048); \
        asm volatile("s_waitcnt lgkmcnt(0)" ::: "memory"); __builtin_amdgcn_sched_barrier(0); out = (bf16x8){l_[0], l_[1], l_[2], l_[3], h_[0], h_[1], h_[2], h_[3]}; } while (0)
__device__ __forceinline__ void unit_decode(int u, int& b, int& h, int& c) { c = u % NCH; const int bh = u / NCH; b = bh / HH; h = bh % HH; }

struct Cum { float gl[16]; float off, g31, g63; };
__device__ __forceinline__ void cum_logf(const float* __restrict__ lf, size_t tok0, int colb, int d, int seg, LAS float* st, Cum& C) {
    float s = 0.f;
#pragma unroll
    for (int i = 0; i < 16; ++i) { s += lf[(tok0 + seg * 16 + i) * HW + colb + d]; C.gl[i] = s; }
    st[seg * 128 + d] = s;
    __syncthreads();
    const float s0 = st[d], s1 = st[128 + d], s2 = st[256 + d], s3 = st[384 + d];
    C.off = seg == 0 ? 0.f : (seg == 1 ? s0 : (seg == 2 ? s0 + s1 : s0 + s1 + s2));
    C.g31 = s0 + s1; C.g63 = (s0 + s1) + (s2 + s3);
}
__device__ __forceinline__ int cum_logf_q(const float* __restrict__ lf, size_t tok0, int colb, int d, int seg, LAS float* st, Cum& C, bool fetch, unsigned* hq, volatile LAS int* nu, int tid) {
    float lv[16];
#pragma unroll
    for (int i = 0; i < 16; ++i) lv[i] = lf[(tok0 + seg * 16 + i) * HW + colb + d];
    int nr = NUN;
    if (fetch && tid == 0) nr = (int)atomicAdd(hq, 1u);
    float s = 0.f;
#pragma unroll
    for (int i = 0; i < 16; ++i) { s += lv[i]; C.gl[i] = s; }
    st[seg * 128 + d] = s;
    if (tid == 0) nu[1] = nr;
    __syncthreads();
    const float s0 = st[d], s1 = st[128 + d], s2 = st[256 + d], s3 = st[384 + d];
    C.off = seg == 0 ? 0.f : (seg == 1 ? s0 : (seg == 2 ? s0 + s1 : s0 + s1 + s2));
    C.g31 = s0 + s1; C.g63 = (s0 + s1) + (s2 + s3);
    return nu[1];
}
#define HG_PF(dst, ptr) asm volatile("global_load_dword %0, %1, off" : "=v"(dst) : "v"(ptr) : "memory")
__device__ __forceinline__ int hg1_unit(const Args& a, int u, char* lds, int tid, bool fetch, unsigned* hq, volatile LAS int* nu, unsigned& pf0) {
    const int lane = tid & 63, wid = __builtin_amdgcn_readfirstlane(tid >> 6), r32 = lane & 31, hi = lane >> 5;
    int b, h, c; unit_decode(u, b, h, c);
    const size_t tok0 = (size_t)b * SEQ + (size_t)c * CH; const int colb = h * HD;
    LAS float* st = (LAS float*)((LAS char*)lds + MISC_OFF);
    const int d = tid & 127, seg = tid >> 7;
    __syncthreads();
    const int sr = tid >> 4, sc = (tid & 15) * 8;
    const bf16x8 v0 = *(const bf16x8*)(a.hv + (tok0 + sr) * HW + colb + sc), v1 = *(const bf16x8*)(a.hv + (tok0 + 32 + sr) * HW + colb + sc);
    bf16 kraw[16];
#pragma unroll
    for (int i = 0; i < 16; ++i) kraw[i] = a.hk[(tok0 + seg * 16 + i) * HW + colb + d];
    Cum C; const int un = cum_logf_q(a.hlogf, tok0, colb, d, seg, st, C, fetch, hq, nu, tid);
    *(bf16x8*)(lds + 16384 + vst<true>(sr, sc)) = v0; *(bf16x8*)(lds + 16384 + vst<true>(32 + sr, sc)) = v1;
    asm volatile("" :: "v"(pf0));
    if (un < NUN) { int nb, nh, nc; unit_decode(un, nb, nh, nc); const size_t tokn = (size_t)nb * SEQ + (size_t)nc * CH; const int coln = nh * HD;
        const int j0 = tid & 127, j1 = tid - 256;
        const void* p0 = tid < 256 ? (const void*)(a.hq + (size_t)(1 + (tid >> 7)) * ((size_t)T * HW) + (tokn + (j0 >> 1)) * HW + coln + (j0 & 1) * 64)
                                   : (const void*)(a.hlogf + (tokn + (j1 >> 2)) * HW + coln + (j1 & 3) * 32);
        HG_PF(pf0, p0); }
#pragma unroll
    for (int i = 0; i < 16; ++i) { const int t = seg * 16 + i; const float kv = bf2f(kraw[i]);
        *(bf16*)(lds + vst<true>(t, d)) = (bf16)pk2(kv * __expf(C.g63 - (C.off + C.gl[i])), 0.f); }
    if (seg == 0) a.hdb[(size_t)u * HD + d] = __expf(C.g63);
    __syncthreads();
    const int vb0 = (int)(uintptr_t)lds + v_rd_base(lane);
    const int db = wid & 3, vp = wid >> 2;
    f32x16 acc0 = {}, acc1 = {};
#define HTRRD2(dst, base, off) asm volatile("ds_read_b64_tr_b16 %0, %1 offset:%2" : "=&v"(dst) : "v"(base), "i"(off) : "memory")
    { const int vA = vb0 + db * 512, vB = vb0 + 16384 + vp * 1024;
      s16x4 al[4], ah[4], bl0[4], bh0[4], bl1[4], bh1[4];
#pragma unroll
      for (int ks = 0; ks < 4; ++ks) { HTRRD2(al[ks], vA, ks * 4096); HTRRD2(ah[ks], vA, ks * 4096 + 2048);
          HTRRD2(bl0[ks], vB, ks * 4096); HTRRD2(bh0[ks], vB, ks * 4096 + 2048); HTRRD2(bl1[ks], vB, 512 + ks * 4096); HTRRD2(bh1[ks], vB, 512 + ks * 4096 + 2048); }
      asm volatile("s_waitcnt lgkmcnt(0)" ::: "memory"); __builtin_amdgcn_sched_barrier(0);
#pragma unroll
      for (int ks = 0; ks < 4; ++ks) {
          const bf16x8 fa = (bf16x8){al[ks][0], al[ks][1], al[ks][2], al[ks][3], ah[ks][0], ah[ks][1], ah[ks][2], ah[ks][3]};
          const bf16x8 fb0 = (bf16x8){bl0[ks][0], bl0[ks][1], bl0[ks][2], bl0[ks][3], bh0[ks][0], bh0[ks][1], bh0[ks][2], bh0[ks][3]};
          const bf16x8 fb1 = (bf16x8){bl1[ks][0], bl1[ks][1], bl1[ks][2], bl1[ks][3], bh1[ks][0], bh1[ks][1], bh1[ks][2], bh1[ks][3]};
          acc0 = __builtin_amdgcn_mfma_f32_32x32x16_bf16(fa, fb0, acc0, 0, 0, 0);
          acc1 = __builtin_amdgcn_mfma_f32_32x32x16_bf16(fa, fb1, acc1, 0, 0, 0); } }
#undef HTRRD2
    bf16* ub = a.hub + (size_t)u * HD * HD + (size_t)(db * 32 + 4 * hi) * HD + vp * 64 + r32;
#pragma unroll
    for (int r = 0; r < 16; ++r) { const int cr = (r & 3) + 8 * (r >> 2);
        const float x0 = acc0[r], x1 = acc1[r]; const float n0 = nbr1(x0), n1 = nbr1(x1);
        if ((r32 & 1) == 0) { *(unsigned*)(ub + (size_t)cr * HD) = cvt_pk_bf16(x0, n0); *(unsigned*)(ub + (size_t)cr * HD + 32) = cvt_pk_bf16(x1, n1); } }
    return un;
}
__device__ __forceinline__ void hg2(const Args& a, int gtid, int gthreads) {
    for (int id = gtid; id < BATCH * HH * HD * (HD / 4); id += gthreads) {
        const int bh = id / (HD * (HD / 4)), rem = id % (HD * (HD / 4)), d = rem >> 5, v4 = (rem & 31) * 4;
        float S0 = 0.f, S1 = 0.f, S2 = 0.f, S3 = 0.f;
        v2u ua[8], ub[8]; float da[8], db[8];
#define HG2_LD(U_, D_, c0_) do { _Pragma("unroll") for (int j = 0; j < 8; ++j) { const size_t un = (size_t)bh * NCH + (c0_) + j; U_[j] = *(const v2u*)(a.hub + un * HD * HD + (size_t)d * HD + v4); D_[j] = a.hdb[un * HD + d]; } } while (0)
#define HG2_RUN(U_, D_, c0_) do { _Pragma("unroll") for (int j = 0; j < 8; ++j) { const size_t un = (size_t)bh * NCH + (c0_) + j;                \
                v2u w; w.x = cvt_pk_bf16(S0, S1); w.y = cvt_pk_bf16(S2, S3); *(v2u*)(a.hsp + un * HD * HD + (size_t)d * HD + v4) = w;                        \
                S0 = D_[j] * S0 + __builtin_bit_cast(float, U_[j].x << 16); S1 = D_[j] * S1 + __builtin_bit_cast(float, U_[j].x & 0xffff0000u);              \
                S2 = D_[j] * S2 + __builtin_bit_cast(float, U_[j].y << 16); S3 = D_[j] * S3 + __builtin_bit_cast(float, U_[j].y & 0xffff0000u); } } while (0)
        HG2_LD(ua, da, 0);
        for (int c0 = 0; c0 < NCH; c0 += 16) {
            HG2_LD(ub, db, c0 + 8);
            HG2_RUN(ua, da, c0);
            if (c0 + 16 < NCH) HG2_LD(ua, da, c0 + 16);
            HG2_RUN(ub, db, c0 + 8);
        }
#undef HG2_LD
#undef HG2_RUN
    }
}
__device__ __forceinline__ void hg2_two(const Args& a, int id0, int id1) {
    constexpr int NIT = BATCH * HH * HD * (HD / 4);
    const int idq[2] = {id0, id1};
    bool ok[2]; size_t ubase[2], dbase[2];
#pragma unroll
    for (int q = 0; q < 2; ++q) { ok[q] = idq[q] >= 0 && idq[q] < NIT; const int id = ok[q] ? idq[q] : 0;
        const int bh = id / (HD * (HD / 4)), rem = id % (HD * (HD / 4)), d = rem >> 5, v4 = (rem & 31) * 4;
        ubase[q] = (size_t)bh * NCH * HD * HD + (size_t)d * HD + v4; dbase[q] = (size_t)bh * NCH * HD + d; }
    float S[2][4] = {{0.f, 0.f, 0.f, 0.f}, {0.f, 0.f, 0.f, 0.f}};
    v2u ua[2][8], ub[2][8]; float da[2][8], db[2][8];
#define HG2_LD(U_, D_, c0_) do { _Pragma("unroll") for (int q = 0; q < 2; ++q) if (ok[q]) { _Pragma("unroll") for (int j = 0; j < 8; ++j) {              \
                U_[q][j] = *(const v2u*)(a.hub + ubase[q] + (size_t)((c0_) + j) * HD * HD); D_[q][j] = a.hdb[dbase[q] + (size_t)((c0_) + j) * HD]; } } } while (0)
#define HG2_RUN(U_, D_, c0_) do { _Pragma("unroll") for (int q = 0; q < 2; ++q) if (ok[q]) { _Pragma("unroll") for (int j = 0; j < 8; ++j) {             \
                v2u w; w.x = cvt_pk_bf16(S[q][0], S[q][1]); w.y = cvt_pk_bf16(S[q][2], S[q][3]); *(v2u*)(a.hsp + ubase[q] + (size_t)((c0_) + j) * HD * HD) = w;   \
                S[q][0] = D_[q][j] * S[q][0] + __builtin_bit_cast(float, U_[q][j].x << 16); S[q][1] = D_[q][j] * S[q][1] + __builtin_bit_cast(float, U_[q][j].x & 0xffff0000u); \
                S[q][2] = D_[q][j] * S[q][2] + __builtin_bit_cast(float, U_[q][j].y << 16); S[q][3] = D_[q][j] * S[q][3] + __builtin_bit_cast(float, U_[q][j].y & 0xffff0000u); } } } while (0)
    if (!ok[0] && !ok[1]) return;
    HG2_LD(ua, da, 0);
    for (int c0 = 0; c0 < NCH; c0 += 16) {
        HG2_LD(ub, db, c0 + 8);
        HG2_RUN(ua, da, c0);
        if (c0 + 16 < NCH) HG2_LD(ua, da, c0 + 16);
        HG2_RUN(ub, db, c0 + 8);
    }
#undef HG2_LD
#undef HG2_RUN
}
__device__ __forceinline__ void hg2_share(const Args& a, int lo, int cnt, int t, int nt) {
    for (int base = 0; base < cnt; base += 2 * nt) { const int i0 = base + t, i1 = base + nt + t; hg2_two(a, i0 < cnt ? lo + i0 : -1, i1 < cnt ? lo + i1 : -1); }
}
struct Hg2Side { const Args* a; int lo, cnt; __device__ __forceinline__ void operator()(int t) const { hg2_share(*a, lo, cnt, t, NTHR - 64); } };
__device__ __forceinline__ int hg3_unit(const Args& a, int l, int u, char* lds, int tid, unsigned* hq, volatile LAS int* nu, unsigned& pf0, unsigned& pf1) {
    const int lane = tid & 63, wid = __builtin_amdgcn_readfirstlane(tid >> 6), r32 = lane & 31, hi = lane >> 5;
    int b, h, c; unit_decode(u, b, h, c);
    const size_t tok0 = (size_t)b * SEQ + (size_t)c * CH; const int colb = h * HD;
    LAS float* st = (LAS float*)((LAS char*)lds + MISC_OFF); LAS float* ps = (LAS float*)((LAS char*)lds + MISC_OFF + 2048);
    const int d = tid & 127, seg = tid >> 7;
    __syncthreads();
    const int sr = tid >> 4, sc = (tid & 15) * 8;
    const bf16x8 v0 = *(const bf16x8*)(a.hv + (tok0 + sr) * HW + colb + sc), v1 = *(const bf16x8*)(a.hv + (tok0 + 32 + sr) * HW + colb + sc);
    bf16x8 spx[4];
    { const bf16* sp = a.hsp + (size_t)u * HD * HD;
#pragma unroll
      for (int i = 0; i < 4; ++i) spx[i] = *(const bf16x8*)(sp + (size_t)(sr + 32 * i) * HD + sc); }
    bf16 qraw[16], kraw[16];
#pragma unroll
    for (int i = 0; i < 16; ++i) { qraw[i] = a.hq[(tok0 + seg * 16 + i) * HW + colb + d]; kraw[i] = a.hk[(tok0 + seg * 16 + i) * HW + colb + d]; }
    const int rgp = wid >> 2, vb = wid & 3;
    int hi4g = 4 * hi; asm volatile("" : "+v"(hi4g));
    const bf16* gp = a.hg + (tok0 + rgp * 32 + hi4g) * HW + colb + vb * 32 + r32;
    bf16 graw[16];
#pragma unroll
    for (int r = 0; r < 16; ++r) graw[r] = gp[(size_t)((r & 3) + 8 * (r >> 2)) * HW];
    const float gn = a.in[18][l * HD + vb * 32 + r32];
    Cum C; const int un = cum_logf_q(a.hlogf, tok0, colb, d, seg, st, C, true, hq, nu, tid);
    *(bf16x8*)(lds + vst<true>(sr, sc)) = v0; *(bf16x8*)(lds + vst<true>(32 + sr, sc)) = v1;
#pragma unroll
    for (int i = 0; i < 4; ++i) { const int dr = sr + 32 * i; *(bf16x8*)(lds + 16384 + (dr >> 6) * 16384 + vst<false>(dr & 63, sc)) = spx[i]; }
    asm volatile("" :: "v"(pf0), "v"(pf1));
    if (un < NUN) { int nb, nh, nc; unit_decode(un, nb, nh, nc); const size_t tokn = (size_t)nb * SEQ + (size_t)nc * CH; const int coln = nh * HD;
        const int j0 = tid & 127;
        const bf16* p0 = a.hq + (size_t)(tid >> 7) * ((size_t)T * HW) + (tokn + (j0 >> 1)) * HW + coln + (j0 & 1) * 64;
        const void* p1 = tid < 256 ? (const void*)(a.hlogf + (tokn + (tid >> 2)) * HW + coln + (tid & 3) * 32) : (const void*)(a.hsp + (size_t)un * HD * HD + (size_t)(tid - 256) * 64);
        HG_PF(pf0, p0); HG_PF(pf1, p1); }
    const float bref = seg >= 2 ? C.g31 : 0.f;
#pragma unroll
    for (int i = 0; i < 16; ++i) { const int t = seg * 16 + i; const float G = C.off + C.gl[i];
        const float qv = bf2f(qraw[i]), kv = bf2f(kraw[i]);
        const int o = HKSWZ(t, d * 2);
        *(bf16*)(lds + 49152 + o) = (bf16)pk2(qv * __expf(G), 0.f);
        *(bf16*)(lds + 65536 + o) = (bf16)pk2(qv * __expf(G - bref), 0.f);
        *(bf16*)(lds + 81920 + o) = (bf16)pk2(kv * __expf(bref - G), 0.f);
        if (seg < 2) *(bf16*)(lds + 98304 + o) = (bf16)pk2(kv * __expf(C.g31 - G), 0.f); }
    __syncthreads();
    const int vb0 = (int)(uintptr_t)lds + v_rd_base(lane);
    f32x16 o = {};
    { const int vS = vb0 + 16384 + vb * 512; s16x4 sl_[8], sh_[8];
#pragma unroll
      for (int ks = 0; ks < 8; ++ks) {
          asm volatile("ds_read_b64_tr_b16 %0, %1 offset:%2" : "=&v"(sl_[ks]) : "v"(vS), "i"((ks >> 2) * 16384 + (ks & 3) * 4096) : "memory");
          asm volatile("ds_read_b64_tr_b16 %0, %1 offset:%2" : "=&v"(sh_[ks]) : "v"(vS), "i"((ks >> 2) * 16384 + (ks & 3) * 4096 + 2048) : "memory"); }
      bf16x8 fa_[8];
#pragma unroll
      for (int ks = 0; ks < 8; ++ks) fa_[ks] = *(const bf16x8*)(lds + 49152 + HKSWZ(rgp * 32 + r32, (ks * 16 + hi * 8) * 2));
      asm volatile("s_waitcnt lgkmcnt(0)" ::: "memory"); __builtin_amdgcn_sched_barrier(0);
#pragma unroll
      for (int ks = 0; ks < 8; ++ks)
          o = __builtin_amdgcn_mfma_f32_32x32x16_bf16(fa_[ks], (bf16x8){sl_[ks][0], sl_[ks][1], sl_[ks][2], sl_[ks][3], sh_[ks][0], sh_[ks][1], sh_[ks][2], sh_[ks][3]}, o, 0, 0, 0); }
#define HPK4(P, B_, OUT) do { unsigned a0 = cvt_pk_bf16(P[B_+0], P[B_+1]), a1 = cvt_pk_bf16(P[B_+2], P[B_+3]);                          \
        unsigned b0 = cvt_pk_bf16(P[B_+4], P[B_+5]), b1 = cvt_pk_bf16(P[B_+6], P[B_+7]);                                             \
        auto r0 = __builtin_amdgcn_permlane32_swap(a0, b0, false, false); auto r1 = __builtin_amdgcn_permlane32_swap(a1, b1, false, false); \
        u32x4 w = {r0[0], r1[0], r0[1], r1[1]}; OUT = *reinterpret_cast<bf16x8*>(&w); } while (0)
    s16x4 vl_[4], vh_[4];
    { const int vV = vb0 + vb * 512;
#pragma unroll
      for (int ks = 0; ks < 4; ++ks) {
          asm volatile("ds_read_b64_tr_b16 %0, %1 offset:%2" : "=&v"(vl_[ks]) : "v"(vV), "i"(ks * 4096) : "memory");
          asm volatile("ds_read_b64_tr_b16 %0, %1 offset:%2" : "=&v"(vh_[ks]) : "v"(vV), "i"(ks * 4096 + 2048) : "memory"); }
      asm volatile("s_waitcnt lgkmcnt(0)" ::: "memory"); __builtin_amdgcn_sched_barrier(0); }
#define HPV(pa, ksv) do { o = __builtin_amdgcn_mfma_f32_32x32x16_bf16(pa, (bf16x8){vl_[ksv][0], vl_[ksv][1], vl_[ksv][2], vl_[ksv][3], vh_[ksv][0], vh_[ksv][1], vh_[ksv][2], vh_[ksv][3]}, o, 0, 0, 0); } while (0)
    { f32x16 p = {};
#pragma unroll
        for (int ks = 0; ks < 8; ++ks) { const int co = HKSWZ(rgp * 32 + r32, (ks * 16 + hi * 8) * 2);
            p = __builtin_amdgcn_mfma_f32_32x32x16_bf16(*(const bf16x8*)(lds + 81920 + co), *(const bf16x8*)(lds + 65536 + co), p, 0, 0, 0); }
#pragma unroll
        for (int r = 0; r < 16; ++r) { const int cr = (r & 3) + 8 * (r >> 2) + 4 * hi; if (cr > r32) p[r] = 0.f; }
        bf16x8 pa0, pa1; HPK4(p, 0, pa0); HPK4(p, 8, pa1);
        if (rgp == 0) { HPV(pa0, 0); HPV(pa1, 1); } else { HPV(pa0, 2); HPV(pa1, 3); } }
    if (rgp == 1) { f32x16 p = {};
#pragma unroll
        for (int ks = 0; ks < 8; ++ks) { const int cb = (ks * 16 + hi * 8) * 2;
            p = __builtin_amdgcn_mfma_f32_32x32x16_bf16(*(const bf16x8*)(lds + 98304 + HKSWZ(r32, cb)), *(const bf16x8*)(lds + 65536 + HKSWZ(32 + r32, cb)), p, 0, 0, 0); }
#pragma unroll
        for (int r = 0; r < 16; ++r) p[r] = fmaxf(p[r], -3.0e38f);
        bf16x8 pa0, pa1; HPK4(p, 0, pa0); HPK4(p, 8, pa1);
        HPV(pa0, 0); HPV(pa1, 1); }
#undef HPK4
#undef HPV
    int hi4 = 4 * hi; asm volatile("" : "+v"(hi4));
#pragma unroll
    for (int r = 0; r < 16; ++r) { const int cr = (r & 3) + 8 * (r >> 2); float ss = o[r] * o[r];
        ss = sum32(ss);
        if (r32 == 0) ps[(rgp * 32 + hi4 + cr) * 4 + vb] = ss; }
    __syncthreads();
    bf16* op = a.mixb + (tok0 + rgp * 32 + hi4) * DM + AW + SW + colb + vb * 32 + r32;
#pragma unroll
    for (int r = 0; r < 16; ++r) { const int cr = (r & 3) + 8 * (r >> 2);
        const f32x4 q = *(const LAS f32x4*)(ps + (rgp * 32 + hi4 + cr) * 4);
        const float rs = __builtin_amdgcn_rsqf(((q[0] + q[1]) + (q[2] + q[3])) * (1.f / 128.f) + EPS);
        const float v = o[r] * rs * gn * bf2f(graw[r]); const float vn = nbr1(v);
        if ((r32 & 1) == 0) *(unsigned*)(op + (size_t)cr * DM) = cvt_pk_bf16(v, vn); }
    return un;
}
#undef HKSWZ
#undef HTRRD
#undef HFRAG
#undef HG_PF
}

namespace att {
typedef short s16x4 __attribute__((ext_vector_type(4)));
typedef float f32x16 __attribute__((ext_vector_type(16)));
typedef unsigned u32x4 __attribute__((ext_vector_type(4)));
constexpr int QB = 128, KVBLK = 64, SHM_V = KVBLK * 128 * 2, SHM_K = KVBLK * 128 * 2;
constexpr int OFF_V = 0, OFF_K = 2 * SHM_V, OFF_X = 65536;
constexpr int OFF_WS = MISC_OFF, OFF_TAB = MISC_OFF + 8192, OFF_C = MISC_OFF + 8192 + AH * 128 * 4;
constexpr int NUNITS = BATCH * AH * (SEQ / QB);
constexpr float SCALE = 0.125f, THR = 8.f;
#define KSWZ(row, colB) ((row) * 256 + ((colB) ^ (((row) & 7) << 4)))
#define SBAR() __builtin_amdgcn_sched_barrier(0)
__device__ __forceinline__ int v_st(int k, int c) { const int kk = (k & ~0xC) | ((k & 4) << 1) | ((k & 8) >> 1); return ((kk >> 3) * 4 + (c >> 5)) * 512 + ((kk & 7) * 32 + (c & 31)) * 2; }
__device__ __forceinline__ int v_rd_base(int lane) { return ((lane & 3) << 3) | (((lane >> 2) & 3) << 6) | (((lane >> 4) & 1) << 5) | (((lane >> 5) & 1) << 8); }
constexpr int v_rd_off(int d0, int ks, int half) { return d0 * 512 + ks * 4096 + half * 2048; }
__device__ __forceinline__ int crow(int r, int hi) { return (r & 3) + 8 * (r >> 2) + 4 * hi; }
__device__ __forceinline__ bf16x8 ld8(const bf16* p) { return *reinterpret_cast<const bf16x8*>(p); }

__device__ __forceinline__ void mask_tile(f32x16& p0, f32x16& p1, int dq) {
    const float NEG = -__builtin_inff();
#pragma unroll
    for (int r = 0; r < 16; ++r) { const int c = (r & 3) + 8 * (r >> 2);
        if (dq - c < 0) p0[r] = NEG;
        if (dq - c - 32 < 0) p1[r] = NEG; }
}
__device__ __forceinline__ void bias_tile(f32x16& p0, f32x16& p1, int dq, const LAS float* tab) {
#pragma unroll
    for (int r = 0; r < 16; ++r) { const int c = (r & 3) + 8 * (r >> 2);
        int d0 = dq - c, d1 = dq - c - 32;
        d0 = d0 < 0 ? 0 : (d0 > 127 ? 127 : d0); d1 = d1 < 0 ? 0 : (d1 > 127 ? 127 : d1);
        p0[r] += tab[d0]; p1[r] += tab[d1]; }
}
__device__ __forceinline__ void partialSM(f32x16& p0, f32x16& p1, float& m_reg, float& mn, float& alpha) {
    float pmax = p0[0];
#pragma unroll
    for (int r = 1; r < 16; ++r) pmax = fmaxf(pmax, p0[r]);
#pragma unroll
    for (int r = 0; r < 16; ++r) pmax = fmaxf(pmax, p1[r]);
    { auto rr = __builtin_amdgcn_permlane32_swap(__float_as_uint(pmax), __float_as_uint(pmax), false, false);
      pmax = fmaxf(__uint_as_float(rr[0]), __uint_as_float(rr[1])); }
    constexpr float C2 = 1.4426950408889634f * SCALE;
    if (__builtin_expect(__all((pmax - m_reg) * SCALE <= THR), 1)) { mn = m_reg; alpha = 1.f; }
    else { mn = fmaxf(m_reg, pmax); alpha = __builtin_amdgcn_exp2f((m_reg - mn) * C2); m_reg = mn; }
    const float mnL = -mn * C2;
#pragma unroll
    for (int r = 0; r < 16; ++r) p0[r] = fmaf(p0[r], C2, mnL);
#pragma unroll
    for (int r = 0; r < 16; ++r) p1[r] = fmaf(p1[r], C2, mnL);
#pragma unroll
    for (int r = 0; r < 16; ++r) p0[r] = __builtin_amdgcn_exp2f(p0[r]);
}
__device__ __forceinline__ void finishSM(f32x16& p0, f32x16& p1, float alpha, float& l_reg, bf16x8& pa0, bf16x8& pa1, bf16x8& pa2, bf16x8& pa3) {
#pragma unroll
    for (int r = 0; r < 16; ++r) p1[r] = __builtin_amdgcn_exp2f(p1[r]);
    float ps = 0;
#pragma unroll
    for (int r = 0; r < 16; ++r) ps += p0[r];
#pragma unroll
    for (int r = 0; r < 16; ++r) ps += p1[r];
    { auto rr = __builtin_amdgcn_permlane32_swap(__float_as_uint(ps), __float_as_uint(ps), false, false);
      ps = __uint_as_float(rr[0]) + __uint_as_float(rr[1]); }
    l_reg = l_reg * alpha + ps;
#define PK4(P, B_, OUT) do { unsigned a0 = cvt_pk_bf16(P[B_+0], P[B_+1]), a1 = cvt_pk_bf16(P[B_+2], P[B_+3]);                          \
        unsigned b0 = cvt_pk_bf16(P[B_+4], P[B_+5]), b1 = cvt_pk_bf16(P[B_+6], P[B_+7]);                                             \
        auto r0 = __builtin_amdgcn_permlane32_swap(a0, b0, false, false); auto r1 = __builtin_amdgcn_permlane32_swap(a1, b1, false, false); \
        u32x4 w = {r0[0], r1[0], r0[1], r1[1]}; OUT = *reinterpret_cast<bf16x8*>(&w); } while (0)
    PK4(p0, 0, pa0); PK4(p0, 8, pa1); PK4(p1, 0, pa2); PK4(p1, 8, pa3);
#undef PK4
}
template <int KB>
__device__ __forceinline__ void qkt(f32x16& p0, f32x16& p1, const char* K_lds, int r32, int hi, int map, const bf16x8* qr) {
    p0 = f32x16{}; p1 = f32x16{};
#pragma unroll
    for (int dd = 0; dd < 4; ++dd) { const char* a = K_lds + KB * SHM_K + KSWZ(r32, (dd * 16 + hi * 8) * 2) + map * 128;
        bf16x8 b0 = *reinterpret_cast<const bf16x8*>(a);
        bf16x8 b1 = *reinterpret_cast<const bf16x8*>(a + 32 * 256);
        p0 = __builtin_amdgcn_mfma_f32_32x32x16_bf16(b0, qr[dd], p0, 0, 0, 0);
        p1 = __builtin_amdgcn_mfma_f32_32x32x16_bf16(b1, qr[dd], p1, 0, 0, 0); }
}
template <int VB>
__device__ __forceinline__ void pv_tile(f32x16* o, int vb0, bf16x8 pa0, bf16x8 pa1, bf16x8 pa2, bf16x8 pa3) {
#define TRRD(dst, off) asm volatile("ds_read_b64_tr_b16 %0, %1 offset:%2" : "=&v"(dst) : "v"(vb0), "i"(off) : "memory")
#define PV_D0(d0) do { s16x4 l0, l1, l2, l3, h0, h1, h2, h3; constexpr int b_ = OFF_V + VB * SHM_V + v_rd_off(d0, 0, 0); \
        TRRD(l0, b_); TRRD(h0, b_ + 2048); TRRD(l1, b_ + 4096); TRRD(h1, b_ + 6144); TRRD(l2, b_ + 8192); TRRD(h2, b_ + 10240); TRRD(l3, b_ + 12288); TRRD(h3, b_ + 14336); \
        asm volatile("s_waitcnt lgkmcnt(0)" ::: "memory"); SBAR();   \
        o[d0] = __builtin_amdgcn_mfma_f32_32x32x16_bf16(pa0, (bf16x8){l0[0], l0[1], l0[2], l0[3], h0[0], h0[1], h0[2], h0[3]}, o[d0], 0, 0, 0);   \
        o[d0] = __builtin_amdgcn_mfma_f32_32x32x16_bf16(pa1, (bf16x8){l1[0], l1[1], l1[2], l1[3], h1[0], h1[1], h1[2], h1[3]}, o[d0], 0, 0, 0);   \
        o[d0] = __builtin_amdgcn_mfma_f32_32x32x16_bf16(pa2, (bf16x8){l2[0], l2[1], l2[2], l2[3], h2[0], h2[1], h2[2], h2[3]}, o[d0], 0, 0, 0);   \
        o[d0] = __builtin_amdgcn_mfma_f32_32x32x16_bf16(pa3, (bf16x8){l3[0], l3[1], l3[2], l3[3], h3[0], h3[1], h3[2], h3[3]}, o[d0], 0, 0, 0); } while (0)
    PV_D0(0); PV_D0(1); PV_D0(2); PV_D0(3);
#undef PV_D0
#undef TRRD
}
struct Ref { const bf16* Q; const bf16* K; const bf16* V; bf16* O; int P0; int h; };
struct Seam { bf16x8 qr[4]; bf16x8 st_v0, st_v1, st_k0, st_k1; };
__device__ __forceinline__ Ref make_ref(int L, const bf16* qb, const bf16* kb, const bf16* vb, bf16* mixb) {
    const int qblk = (SEQ / QB - 1) - L / (BATCH * AH), bh = L % (BATCH * AH), b = bh / AH, h = bh % AH;
    Ref r; const size_t t0 = (size_t)b * SEQ;
    r.Q = qb + (t0 + (size_t)qblk * QB) * AW + h * 128; r.K = kb + t0 * AW + h * 128; r.V = vb + t0 * AW + h * 128;
    r.O = mixb + (t0 + (size_t)qblk * QB) * DM + h * 128; r.P0 = qblk * QB; r.h = h; return r;
}
#define ROW(p, k0, rr) ((p) + (size_t)((k0) + (rr)) * AW + sc)
#define VMW() asm volatile("s_waitcnt vmcnt(0)" ::: "memory")
#define VMWN(n) asm volatile("s_waitcnt vmcnt(%0)" :: "i"(n) : "memory")
#define SLOAD_H(Kp, Vp, k0) do { S.st_v0 = ld8(ROW(Vp, k0, sr)); S.st_v1 = ld8(ROW(Vp, k0, 32 + sr)); S.st_k0 = ld8(ROW(Kp, k0, sr)); S.st_k1 = ld8(ROW(Kp, k0, 32 + sr)); } while (0)
#define SLOAD_K(Kp, k0) do { S.st_k0 = ld8(ROW(Kp, k0, sr)); S.st_k1 = ld8(ROW(Kp, k0, 32 + sr)); } while (0)
#define SLOAD_V(Vp, k0) do { S.st_v0 = ld8(ROW(Vp, k0, sr)); S.st_v1 = ld8(ROW(Vp, k0, 32 + sr)); } while (0)
#define SWRITE_HK(bf) do { *(bf16x8*)(K_lds + (bf) * SHM_K + kws) = S.st_k0; *(bf16x8*)(K_lds + (bf) * SHM_K + kws + 32 * 256) = S.st_k1; } while (0)
#define SWRITE_HV(bf) do { *(bf16x8*)(V_lds + (bf) * SHM_V + vst0) = S.st_v0; *(bf16x8*)(V_lds + (bf) * SHM_V + vst1) = S.st_v1; } while (0)
#define SWRITE_H(bf) do { SWRITE_HV(bf); SWRITE_HK(bf); } while (0)
__device__ __forceinline__ void prime(const Ref& cur, char* lds, Seam& S) {
    const int tid = tidx(), wid = __builtin_amdgcn_readfirstlane(tid >> 6), lane = tid & 63, r32 = lane & 31, hi = lane >> 5, rg = wid & 3, map = wid >> 2;
    const int sr = tid >> 4, sc = (tid & 15) * 8, kws = KSWZ(sr, sc * 2); char* K_lds = lds + OFF_K;
#pragma unroll
    for (int dd = 0; dd < 4; ++dd) S.qr[dd] = ld8(cur.Q + (size_t)(rg * 32 + r32) * AW + map * 64 + dd * 16 + hi * 8);
    SLOAD_H(cur.K, cur.V, 0); VMW(); SWRITE_HK(0);
    __syncthreads();
}
__device__ __forceinline__ void block(const Ref& cur, const Ref& nxt, char* lds, Seam& S, const float lam, const float osc, const float* __restrict__ subg) {
    const int tid = tidx(), wid = __builtin_amdgcn_readfirstlane(tid >> 6), lane = tid & 63, r32 = lane & 31, hi = lane >> 5, rg = wid & 3, map = wid >> 2;
    const int NT = cur.P0 / KVBLK + 2;
    const int qlo = cur.P0 + rg * 32, qm = qlo + r32 - 4 * hi;
    char* V_lds = lds + OFF_V; char* K_lds = lds + OFF_K;
    LAS float* wsf = (LAS float*)((LAS char*)lds + OFF_WS) + wid * 64; LAS float* li_l = wsf; LAS float* al_l = wsf + 32;
    const LAS float* tab = (const LAS float*)((LAS char*)lds + OFF_TAB) + cur.h * 128;
    float m_reg = -1e30f, l_reg = 0; f32x16 o[4] = {};
    const int sr = tid >> 4, sc = (tid & 15) * 8, vst0 = v_st(sr, sc), vst1 = v_st(32 + sr, sc), kws = KSWZ(sr, sc * 2);
    const int vb0 = (int)(uintptr_t)lds + v_rd_base(lane);
    const bf16* Kh = cur.K; const bf16* Vh = cur.V;
#define RESC(a) do { if (__any((a) < 1.f)) { if (hi == 0) al_l[r32] = (a); asm volatile("s_waitcnt lgkmcnt(0)" ::: "memory");              \
                     for (int d_ = 0; d_ < 4; ++d_) for (int r = 0; r < 16; ++r) o[d_][r] *= al_l[crow(r, hi)]; } } while (0)
#define KBASE(t) ((t) * KVBLK)
#define MASKT(P0_, P1_, t) do { const int kb_ = KBASE(t); if (kb_ + KVBLK - 1 + 113 > qlo) { bias_tile(P0_, P1_, qm - kb_, tab); if (kb_ + KVBLK - 1 > qlo) mask_tile(P0_, P1_, qm - kb_); } } while (0)
#define SEAM_K0() do { VMWN(4); SWRITE_HK(0); SBAR(); } while (0)
    f32x16 pA0, pA1, pB0, pB1; float mnA, mnB, alA, alB; bf16x8 pa0, pa1, pa2, pa3;
    SWRITE_HV(0); SBAR();
    SLOAD_H(Kh, Vh, KBASE(1));
    SBAR(); qkt<0>(pA0, pA1, K_lds, r32, hi, map, S.qr);
    MASKT(pA0, pA1, 0); partialSM(pA0, pA1, m_reg, mnA, alA);
    VMW(); SWRITE_HK(1); SBAR();
    if (2 < NT) { SLOAD_K(Kh, KBASE(2)); SBAR(); }
    __syncthreads();
#define HALF_STEP(PX0, PX1, mnX, alX, PY0, PY1, alY, t, KB, VB) do {                                                          \
        SBAR(); qkt<KB>(PX0, PX1, K_lds, r32, hi, map, S.qr);                                                                 \
        finishSM(PY0, PY1, alY, l_reg, pa0, pa1, pa2, pa3); SBAR();                                                           \
        VMW(); SWRITE_HV(KB); SWRITE_HK(1 - KB); SBAR();                                                                      \
        SLOAD_V(Vh, KBASE((t) + 1)); if ((t) + 2 < NT) SLOAD_K(Kh, KBASE((t) + 2)); SBAR();                                   \
        pv_tile<VB>(o, vb0, pa0, pa1, pa2, pa3); MASKT(PX0, PX1, (t)); partialSM(PX0, PX1, m_reg, mnX, alX);                  \
        RESC(alX); __syncthreads(); } while (0)
    for (int t = 1; t + 1 < NT; t += 2) {
        HALF_STEP(pB0, pB1, mnB, alB, pA0, pA1, alA, t, 1, 0);
        HALF_STEP(pA0, pA1, mnA, alA, pB0, pB1, alB, t + 1, 0, 1);
    }
    SBAR(); qkt<1>(pB0, pB1, K_lds, r32, hi, map, S.qr); SBAR();
    finishSM(pA0, pA1, alA, l_reg, pa0, pa1, pa2, pa3); SBAR();
    VMW(); SWRITE_HV(1); SBAR();
    SLOAD_H(nxt.K, nxt.V, 0); SBAR();
#pragma unroll
    for (int dd = 0; dd < 4; ++dd) S.qr[dd] = ld8(nxt.Q + (size_t)(rg * 32 + r32) * AW + map * 64 + dd * 16 + hi * 8);
    SBAR();
    pv_tile<0>(o, vb0, pa0, pa1, pa2, pa3);
    MASKT(pB0, pB1, NT - 1); partialSM(pB0, pB1, m_reg, mnB, alB); RESC(alB); __syncthreads();
    finishSM(pB0, pB1, alB, l_reg, pa0, pa1, pa2, pa3); SBAR(); pv_tile<1>(o, vb0, pa0, pa1, pa2, pa3);
    SBAR(); SEAM_K0();
    if (hi == 0) li_l[r32] = l_reg; asm volatile("s_waitcnt lgkmcnt(0)" ::: "memory");
    int hi4 = 4 * hi; asm volatile("" : "+v"(hi4));
    LAS float* Xl = (LAS float*)((LAS char*)lds + OFF_X) + (rg * 32 + hi4) * 128 + r32;
    const LAS float* lil = li_l + hi4;
    const float sc1 = map ? lam : 1.f;
#pragma unroll
    for (int r = 0; r < 16; ++r) { constexpr int dummy = 0; (void)dummy; const int cr = (r & 3) + 8 * (r >> 2);
        const float rl = __builtin_amdgcn_rcpf(lil[cr]) * sc1;
#pragma unroll
        for (int d0 = 0; d0 < 4; ++d0) o[d0][r] *= rl; }
    if (map) {
#pragma unroll
        for (int r = 0; r < 16; ++r) { const int cr = (r & 3) + 8 * (r >> 2);
#pragma unroll
            for (int d0 = 0; d0 < 4; ++d0) Xl[cr * 128 + d0 * 32] = o[d0][r]; }
    }
    __syncthreads();
    if (!map) {
        float g4[4];
#pragma unroll
        for (int d0 = 0; d0 < 4; ++d0) g4[d0] = subg[d0 * 32 + r32] * osc;
        bf16* Ow = cur.O + (size_t)(rg * 32 + hi4) * DM + r32;
#pragma unroll
        for (int r = 0; r < 16; ++r) { const int cr = (r & 3) + 8 * (r >> 2); float ss = 0.f;
#pragma unroll
            for (int d0 = 0; d0 < 4; ++d0) { o[d0][r] -= Xl[cr * 128 + d0 * 32]; ss += o[d0][r] * o[d0][r]; }
            ss = sum32(ss);
            const float rs = __builtin_amdgcn_rsqf(ss * (1.f / 128.f) + EPS);
            bf16* orp = Ow + (size_t)cr * DM;
#pragma unroll
            for (int d0 = 0; d0 < 4; ++d0) { const float v = o[d0][r] * rs * g4[d0]; const float vn = nbr1(v);
                if ((r32 & 1) == 0) *(unsigned*)(orp + d0 * 32) = cvt_pk_bf16(v, vn); } }
    }
#undef RESC
#undef KBASE
#undef MASKT
#undef SEAM_K0
#undef HALF_STEP
}
#undef ROW
#undef VMW
#undef VMWN
#undef SLOAD_H
#undef SLOAD_K
#undef SLOAD_V
#undef SWRITE_HK
#undef SWRITE_HV
#undef SWRITE_H
constexpr int NSLOTS = 198;
__device__ __forceinline__ void slot_units(int slot, int& L0, int& L1) {
    if (slot < 12) { L0 = slot; L1 = -1; }
    else if (slot < 192) { const int j = slot - 12, pp = j / 12, bh = j % 12; L0 = (1 + pp) * 12 + bh; L1 = (31 - pp) * 12 + bh; }
    else { const int j = slot - 192; L0 = 192 + 2 * j; L1 = 192 + 2 * j + 1; }
}
__device__ __forceinline__ int unit_at(int k, int me, int nworkers) {
    const int slot = me + (k >> 1) * nworkers; if (slot >= NSLOTS) return -1;
    int L0, L1; slot_units(slot, L0, L1); return (k & 1) ? L1 : L0;
}
__device__ __forceinline__ void make_tables(char* lds, const float* rel_bias, const float* lamv, int layer, int t, int nt) {
    LAS float* tabs = (LAS float*)((LAS char*)lds + OFF_TAB); LAS float* cst = (LAS float*)((LAS char*)lds + OFF_C);
    for (int i = t; i < AH * 128; i += nt) { const int h = i >> 7, d = i & 127; tabs[i] = (rel_bias[t5_bucket(d) * AH + h] - rel_bias[31 * AH + h]) * (1.f / SCALE); }
    if (t < 64) { const float lam_init = 0.8f - 0.6f * expf(-0.3f * (float)layer);
        float d01 = wave_sum(lamv[t] * lamv[64 + t]), d23 = wave_sum(lamv[128 + t] * lamv[192 + t]);
        if (t == 0) cst[0] = expf(d01) - expf(d23) + lam_init; }
}
__device__ __forceinline__ void phase_static(char* lds, const bf16* qb, const bf16* kb, const bf16* vb, bf16* mixb, const float* rel_bias, const float* lamv, const float* subg, int layer, int me, int nworkers) {
    const int tid = tidx(), lane = tid & 63;
    LAS float* cst = (LAS float*)((LAS char*)lds + OFF_C);
    const float lam_init = 0.8f - 0.6f * expf(-0.3f * (float)layer);
    (void)lane; (void)rel_bias; (void)lamv;
    __syncthreads();
    const float lam = cst[0], osc = 1.f - lam_init;
    int k = 0; int L = unit_at(0, me, nworkers);
    if (L < 0) return;
    Ref cur = make_ref(L, qb, kb, vb, mixb);
    Seam S;
    prime(cur, lds, S);
    for (;;) {
        int kn = k + 1; int Ln = unit_at(kn, me, nworkers);
        if (Ln < 0 && (kn & 1)) { kn = k + 2; Ln = unit_at(kn, me, nworkers); }
        const bool last = Ln < 0;
        const Ref nxt = last ? cur : make_ref(Ln, qb, kb, vb, mixb);
        block(cur, nxt, lds, S, lam, osc, subg);
        if (last) break;
        cur = nxt; k = kn;
    }
}
#undef KSWZ
#undef SBAR
}

__device__ __forceinline__ void stats_route_tile(const Args& a, int l, int tile, char* lds, int tid) {
    typedef float f32x16 __attribute__((ext_vector_type(16)));
    const int lane = tid & 63, w = __builtin_amdgcn_readfirstlane(tid >> 6), r32 = lane & 31, hi = lane >> 5;
    LAS float* red = (LAS float*)(LAS char*)lds;
    LAS float* ssp = red + 8 * 32 * 64;
    LAS float* lg = ssp + 256;
    LAS float* rsd = lg + 2048;
    const bf16* wh = a.wrh + (size_t)l * 64 * DM; const bf16* wl = a.wrl + (size_t)l * 64 * DM;
    const size_t row = (size_t)tile * 32 + r32;
    f32x16 acc0 = {}, acc1 = {}; float ssq = 0.f;
    __syncthreads();
#pragma unroll 4
    for (int sp = 0; sp < 8; ++sp) { const int k0 = w * 256 + sp * 32 + 16 * hi;
        const bf16* hp = a.hb + row * DM + k0;
        const v4u ahh[2] = {*(const v4u*)hp, *(const v4u*)(hp + 8)};
#pragma unroll
        for (int q = 0; q < 2; ++q) { const v4u ah = ahh[q]; const unsigned au[4] = {ah.x, ah.y, ah.z, ah.w};
#pragma unroll
            for (int e = 0; e < 4; ++e) { const float lo_ = __builtin_bit_cast(float, au[e] << 16), hi_ = __builtin_bit_cast(float, au[e] & 0xffff0000u); ssq += lo_ * lo_ + hi_ * hi_; }
            const bf16x8 fah = __builtin_bit_cast(bf16x8, ah);
            const size_t fo = ((size_t)((w * 16 + 2 * sp + q) * 2) * 64 + lane) * 8;
            const bf16x8 bh0 = *(const bf16x8*)(wh + fo), bl0 = *(const bf16x8*)(wl + fo);
            const bf16x8 bh1 = *(const bf16x8*)(wh + fo + 512), bl1 = *(const bf16x8*)(wl + fo + 512);
            acc0 = __builtin_amdgcn_mfma_f32_32x32x16_bf16(fah, bh0, acc0, 0, 0, 0); acc0 = __builtin_amdgcn_mfma_f32_32x32x16_bf16(fah, bl0, acc0, 0, 0, 0);
            acc1 = __builtin_amdgcn_mfma_f32_32x32x16_bf16(fah, bh1, acc1, 0, 0, 0); acc1 = __builtin_amdgcn_mfma_f32_32x32x16_bf16(fah, bl1, acc1, 0, 0, 0); } }
    { auto rr = __builtin_amdgcn_permlane32_swap(__float_as_uint(ssq), __float_as_uint(ssq), false, false); ssq = __uint_as_float(rr[0]) + __uint_as_float(rr[1]); }
    if (hi == 0) ssp[w * 32 + r32] = ssq;
#pragma unroll
    for (int r = 0; r < 16; ++r) { const int tr = (r & 3) + 8 * (r >> 2) + 4 * hi;
        red[(w * 32 + tr) * 64 + r32] = acc0[r]; red[(w * 32 + tr) * 64 + 32 + r32] = acc1[r]; }
    __syncthreads();
#pragma unroll
    for (int q = 0; q < 4; ++q) { const int o = tid + q * NTHR; float s = 0.f;
#pragma unroll
        for (int ww = 0; ww < 8; ++ww) s += red[ww * 2048 + o];
        lg[o] = s; }
    if (tid < 32) { float s = 0.f;
#pragma unroll
        for (int ww = 0; ww < 8; ++ww) s += ssp[ww * 32 + tid];
        const float rs = 1.0f / sqrtf(s * (1.f / DM) + EPS); rsd[tid] = rs; a.rstd[tile * 32 + tid] = rs; }
    __syncthreads();
    if (tid < 32) { const int t = tile * 32 + tid; const float rs = rsd[tid]; const LAS float* L = lg + tid * 64;
        float g4[4];
#pragma unroll
        for (int j = 0; j < 4; ++j) g4[j] = L[j] * rs;
        int gi = 0; float gm = g4[0];
#pragma unroll
        for (int j = 1; j < 4; ++j) if (g4[j] > gm) { gm = g4[j]; gi = j; }
        float gs = 0.f;
#pragma unroll
        for (int j = 0; j < 4; ++j) gs += expf(g4[j] - gm);
        const float pg = 1.f / gs;
        float el[8];
#pragma unroll
        for (int j = 0; j < 8; ++j) el[j] = L[4 + gi * 8 + j] * rs;
        int i1 = 0; float v1 = el[0];
#pragma unroll
        for (int j = 1; j < 8; ++j) if (el[j] > v1) { v1 = el[j]; i1 = j; }
        int i2 = -1; float v2 = -INFINITY;
#pragma unroll
        for (int j = 0; j < 8; ++j) if (j != i1 && el[j] > v2) { v2 = el[j]; i2 = j; }
        const float e2 = expf(v2 - v1), den = 1.f + e2;
        const int e0 = gi * 8 + i1, e1 = gi * 8 + i2;
        int* cnt = (int*)(a.ctl + 65536 + l * 4096);
        LAS int* lcnt = (LAS int*)(rsd + 32); LAS int* lbase = lcnt + 32;
        lcnt[tid] = 0;
        const int r0 = atomicAdd((int*)&lcnt[e0], 1), r1 = atomicAdd((int*)&lcnt[e1], 1);
        { const int c = lcnt[tid]; lbase[tid] = c > 0 ? atomicAdd(&cnt[tid * 64], c) : 0; }
        const int p0 = lbase[e0] + r0, p1 = lbase[e1] + r1;
        a.tokl[(size_t)e0 * T + p0] = t; a.tokl[(size_t)e1 * T + p1] = t;
        a.gl[(size_t)e0 * T + p0] = pg / den; a.gl[(size_t)e1 * T + p1] = pg * e2 / den;
        a.sl[t * 2] = (e0 << 16) | p0; a.sl[t * 2 + 1] = (e1 << 16) | p1; }
}

#define XB_TMO      128
#define XB_XCNT(j)  (256  + 64 * (j))
#define XB_XSUB(j)  (1280 + 64 * (j))
#define XB_XGEN(j)  (2304 + 64 * (j))
#define XB_TOP      3328
#define XB_TOPGEN   3392
#define XCD_BAR_WORDS 3456
__device__ __forceinline__ unsigned xb_ld(unsigned* p)              { return __hip_atomic_load(p, __ATOMIC_RELAXED, __HIP_MEMORY_SCOPE_AGENT); }
__device__ __forceinline__ unsigned xb_add(unsigned* p, unsigned v) { return __hip_atomic_fetch_add(p, v, __ATOMIC_RELAXED, __HIP_MEMORY_SCOPE_AGENT); }
__device__ __forceinline__ unsigned xb_xcc_id() { return (unsigned)__builtin_amdgcn_s_getreg((3 << 11) | 20) & 0xFu; }
#define XB_SPIN(cond, bar) do { unsigned _sp = 0; while (cond) { __builtin_amdgcn_s_sleep(1); \
    if ((++_sp & 255u) == 0u) { if (xb_ld(&(bar)[XB_TMO])) break; if (_sp > XB_SPIN_CAP) { atomicAdd(&(bar)[XB_TMO], 1u); break; } } } } while (0)
struct XcdBarrier { unsigned* bar; unsigned x; volatile LAS unsigned* st; };
__device__ __forceinline__ XcdBarrier xcd_barrier_post(unsigned* bar, volatile LAS unsigned* st) {
    XcdBarrier b; b.bar = bar; b.x = xb_xcc_id(); b.st = st;
    if (tidx() == 0) (void)xb_add(&bar[XB_XCNT(b.x)], 1u);
    return b;
}
__device__ __forceinline__ void xcd_barrier_complete(unsigned* bar, unsigned x, unsigned& nloc, unsigned& nx) {
    const unsigned G = gridDim.x * gridDim.y * gridDim.z;
    unsigned sum, cnt, mine, sp = 0u;
    for (;;) {
        sum = 0u; cnt = 0u; mine = 0u;
#pragma unroll
        for (unsigned j = 0; j < 16; ++j) { const unsigned c = xb_ld(&bar[XB_XCNT(j)]); sum += c; cnt += (c > 0u) ? 1u : 0u; }
        mine = xb_ld(&bar[XB_XCNT(x)]);
        if (sum == G) break;
        __builtin_amdgcn_s_sleep(1);
        if ((++sp & 255u) == 0u) { if (xb_ld(&bar[XB_TMO])) break; if (sp > XB_SPIN_CAP) { atomicAdd(&bar[XB_TMO], 1u); break; } }
    }
    nloc = mine > 0u ? mine : 1u; nx = cnt > 0u ? cnt : 1u;
}
__device__ __forceinline__ void xcd_barrier(const XcdBarrier& b, char* tab_lds = nullptr, const float* tab_bias = nullptr, const float* tab_lam = nullptr, int tab_layer = 0) {
    asm volatile("s_waitcnt vmcnt(0)" ::: "memory");
    __syncthreads();
    if (tab_lds != nullptr && tidx() >= 64) att::make_tables(tab_lds, tab_bias, tab_lam, tab_layer, tidx() - 64, NTHR - 64);
    if (tidx() == 0) {
        unsigned* bar = b.bar;
        __builtin_amdgcn_s_waitcnt(0);
        unsigned nloc = b.st[0], nx = b.st[1];
        if (nloc == 0u) { xcd_barrier_complete(bar, b.x, nloc, nx); b.st[0] = nloc; b.st[1] = nx; }
        const unsigned old = xb_add(&bar[XB_XSUB(b.x)], 1u);
        const unsigned gen = old / nloc;
        if (old + 1u == (gen + 1u) * nloc) {
            __builtin_amdgcn_fence(__ATOMIC_RELEASE, "agent");
            asm volatile("s_waitcnt vmcnt(0)" ::: "memory");
            const unsigned og = xb_add(&bar[XB_TOP], 1u);
            const unsigned tg = og / nx;
            if (og + 1u == (tg + 1u) * nx) xb_add(&bar[XB_TOPGEN], 1u);
            else XB_SPIN(xb_ld(&bar[XB_TOPGEN]) == tg, bar);
            __builtin_amdgcn_fence(__ATOMIC_ACQUIRE, "agent");
            xb_add(&bar[XB_XGEN(b.x)], 1u);
            asm volatile("s_waitcnt vmcnt(0)" ::: "memory");
        } else {
            XB_SPIN(xb_ld(&bar[XB_XGEN(b.x)]) == gen, bar);
            __builtin_amdgcn_fence(__ATOMIC_ACQUIRE, "agent");
            asm volatile("s_waitcnt vmcnt(0)" ::: "memory");
        }
    }
    __syncthreads();
}

__device__ __forceinline__ void sub_barrier(unsigned* ctr, unsigned n, unsigned gen, unsigned* tmo) {
    asm volatile("s_waitcnt vmcnt(0)" ::: "memory");
    __syncthreads();
    if (tidx() == 0) {
        __builtin_amdgcn_fence(__ATOMIC_RELEASE, "agent");
        asm volatile("s_waitcnt vmcnt(0)" ::: "memory");
        xb_add(ctr, 1u);
        unsigned sp = 0;
        while (xb_ld(ctr) < n * (gen + 1u)) { __builtin_amdgcn_s_sleep(1); if ((++sp & 255u) == 0u) { if (xb_ld(tmo)) break; if (sp > XB_SPIN_CAP) { atomicAdd(tmo, 1u); break; } } }
        __builtin_amdgcn_fence(__ATOMIC_ACQUIRE, "agent");
        asm volatile("s_waitcnt vmcnt(0)" ::: "memory");
    }
    __syncthreads();
}

enum { OP_PRO = 0, OP_INPROJ = 1, OP_OUTPROJ = 2, OP_STATS = 3, OP_PROMOE = 4, OP_MOEGU = 5, OP_MOEDOWN = 6, OP_COMBINE = 7, OP_ATTN = 8, OP_PROS5 = 9, OP_S5A = 10, OP_S5B = 11, OP_S5C = 12, OP_GLU = 13, OP_HG1 = 14, OP_HG2 = 15, OP_HG3 = 16, OP_MIX = 17, OP_P1 = 18 };
constexpr int NPROG = 11;
__constant__ int c_prog[NPROG] = { OP_PRO, OP_INPROJ | (0 << 8), OP_MIX | (0 << 8), OP_OUTPROJ | (0 << 8), OP_MOEGU | (0 << 8), OP_COMBINE | (0 << 8), OP_INPROJ | (1 << 8) | 0x10000, OP_MIX | (1 << 8), OP_OUTPROJ | (1 << 8), OP_MOEGU | (1 << 8), OP_COMBINE | (1 << 8) };

__global__ void __launch_bounds__(NTHR, 2) mega(KArgs a) {
    extern __shared__ __attribute__((aligned(16))) unsigned char lds_raw[];
    LAS unsigned char* lds = (LAS unsigned char*)lds_raw;
    const int G = gridDim.x;
    volatile LAS unsigned* bst = (volatile LAS unsigned*)(lds + LDS_BYTES - 64);
    if (tidx() < 16) bst[tidx()] = 0u;
    __syncthreads();
    unsigned* barw = (unsigned*)(a.ws + O_CTL) + 4096;
    XcdBarrier bar; bar.bar = barw; bar.x = 0; bar.st = bst;
    if (a.nprog > 1) bar = xcd_barrier_post(barw, bst);
#define PH_IDS const int tid = tidx(), lane = tid & 63, wave = __builtin_amdgcn_readfirstlane(tid >> 6); \
    const int vcu = (G % 8 == 0) ? (bx % 8) * (G / 8) + bx / 8 : bx; const int gw = vcu * NWAVES + wave, NGW = G * NWAVES; (void)lane; (void)gw; (void)NGW; (void)tid
  const int pi_lo = a.pi0, pi_hi = a.pi0 + a.nprog;
  if (pi_lo == 0) {
    typedef const __attribute__((address_space(4))) KArgs* KP;
    KP kp = (KP)__builtin_amdgcn_kernarg_segment_ptr(); asm volatile("" : "+s"(kp));
    Args A;
#pragma unroll
    for (int i_ = 0; i_ < 25; ++i_) A.in[i_] = kp->in[i_];
    A.out = kp->out; fill_ws(A, kp->ws);
    int bx = blockIdx.x; asm volatile("" : "+s"(bx));
    PH_IDS;
    for (int it = bx; it < DEPTH * SG; it += G) s5_tables(A, it / SG, it % SG, (LAS float*)lds, tid);
    LAS float* scr = (LAS float*)(lds + 65536 + wave * 8448);
    { constexpr int I_G = (DM / 64) * (DE / 32), I_D = (DE / 64) * (DM / 32);
      { MkMoeD mk{A.in[23], A.wd_t, -(DEPTH * NE * I_D)}; tr_loop<false>(mk, DEPTH * NE * I_D, gw, NGW, scr, lane); }
      { MkMoeGU mk{A.in[21], A.in[22], A.in[4], A.wgu_t, -(DEPTH * NE * 2 * I_G)}; tr_loop<true>(mk, NE * 2 * I_G - 2 * CONV_S, gw, NGW, scr, lane); }
      { MkMoeGU mk{A.in[21], A.in[22], A.in[4], A.wgu_t, -(NE * 2 * I_G)}; tr_loop<true>(mk, NE * 2 * I_G, gw, NGW, scr, lane); } }
    { constexpr int I_IN = (DM / 64) * (INC / 32), I_OUT = (DM / 64) * (DM / 32);
      { MkIn mk{A.in[1], A.in[3], A.win_t, 0}; tr_loop<true>(mk, DEPTH * I_IN, gw, NGW, scr, lane); }
      { MkOut mk{A.in[2], A.wout_t, 0}; tr_loop<false>(mk, DEPTH * I_OUT, gw, NGW, scr, lane); } }
    for (int m0 = gw * 4; m0 < T; m0 += NGW * 4)
        for (int m = m0; m < m0 + 4 && m < T; ++m) stats_row(A.in[0] + (size_t)m * DM, A.hb + (size_t)m * DM, A.rstd + m, lane);
    for (int i = gw * 64 + lane; i < DEPTH * (INCP - INC) * DM / 8; i += NGW * 64) {
        const int ll = i / ((INCP - INC) * DM / 8), r = i % ((INCP - INC) * DM / 8);
        *(GAS v4u*)(A.win_t + (size_t)ll * INCP * DM + (size_t)INC * DM + (size_t)r * 8) = (v4u){0u, 0u, 0u, 0u};
    }
    for (int i = gw * 64 + lane; i < DEPTH * HW; i += NGW * 64) {
        const int ll = i / HW, ch = i % HW;
        float lb = 0.f;
        if (ll == 1) { const float l0 = A.in[17][ch], l1 = A.in[17][HW + ch]; lb = 1.f / (1.f + expf(l0 - l1)); }
        A.lbt[i * 2] = lb; A.lbt[i * 2 + 1] = 1.f - lb;
    }
    for (int i = gw * 64 + lane; i < DEPTH * 64 * DM; i += NGW * 64) { const int ll = i / (64 * DM), q = i % (64 * DM);
        const int jj = q & 7, ln = (q >> 3) & 63, nt = (q >> 9) & 1, ks = q >> 10;
        const int j = nt * 32 + (ln & 31), k = (ks >> 1) * 32 + 16 * (ln >> 5) + 8 * (ks & 1) + jj;
        float wv = 0.f;
        if (j < 4) wv = A.in[19][((size_t)ll * DM + k) * NGRP + j]; else if (j < 36) wv = A.in[20][((size_t)ll * DM + k) * NE + (j - 4)];
        wv *= A.in[4][ll * DM + k];
        const unsigned hb_ = f2bf(wv); const float lo = wv - __builtin_bit_cast(float, hb_ << 16);
        A.wrh[i] = (bf16)hb_; A.wrl[i] = (bf16)f2bf(lo); }
    { constexpr int I_GL = (SW / 64) * (SW / 32);
      MkGlu mk{A.in[16], A.wglu_t}; tr_loop<false>(mk, DEPTH * I_GL, gw, NGW, scr, lane);
      for (int i = gw * 64 + lane; i < DEPTH * 128 * SW / 8; i += NGW * 64) { const int ll = i / (128 * SW / 8), r = i % (128 * SW / 8);
          *(GAS v4u*)(A.wglu_t + (size_t)ll * 768 * SW + (size_t)SW * SW + (size_t)r * 8) = (v4u){0u, 0u, 0u, 0u}; } }
  }
  for (int pi = (pi_lo > 1 ? pi_lo : 1); pi < pi_hi; ++pi) {
    const int pw = c_prog[pi], op_ = pw & 255, l = (pw >> 8) & 255;
    if (pi > pi_lo && !(pw & 0x10000)) {
        if (op_ == OP_MIX) { typedef const __attribute__((address_space(4))) KArgs* KQ; KQ kq = (KQ)__builtin_amdgcn_kernarg_segment_ptr(); asm volatile("" : "+s"(kq));
            xcd_barrier(bar, (char*)lds_raw, kq->in[5], kq->in[6] + l * 4 * DK, l); }
        else xcd_barrier(bar); }
    typedef const __attribute__((address_space(4))) KArgs* KP;
    KP kp = (KP)__builtin_amdgcn_kernarg_segment_ptr(); asm volatile("" : "+s"(kp));
    Args A;
#pragma unroll
    for (int i_ = 0; i_ < 25; ++i_) A.in[i_] = kp->in[i_];
    A.out = kp->out; fill_ws(A, kp->ws);
    int bx = blockIdx.x; asm volatile("" : "+s"(bx));
    int G_ = gridDim.x; asm volatile("" : "+s"(G_)); const int G = G_;

    if (op_ == OP_INPROJ) {
        pg8::DenseOrder S; S.init(A.hb, A.win_t + (size_t)l * INCP * DM, T, INCP, DM, G, bx);
        if (l > 0) { S.ready = A.ctl + 49152 + (l - 1) * 1024; S.need = 64u; S.tmo = A.ctl + 4096 + XB_TMO; }
        EpiProj E{A.rstd, A.qb, A.kb, A.vb, A.ug, A.hq, A.hk, A.hv, A.hg, A.hlogf, A.lbt + l * HW * 2};
        pg8::gemm_phase<EpiProj, pg8::DenseOrder, false>(lds, S, E);
        { const int nun = (T / 256) * (INCP / 256), full = nun / G, nidle = G - (nun - full * G);
          if (nidle < G && bx >= G - nidle) {
              __syncthreads();
              const int tid_ = tidx(), lane_ = tid_ & 63, wave_ = __builtin_amdgcn_readfirstlane(tid_ >> 6);
              LAS float* scr = (LAS float*)(lds + 65536 + wave_ * 8448);
              constexpr int I_G = (DM / 64) * (DE / 32);
              MkMoeGU mk{A.in[21], A.in[22], A.in[4], A.wgu_t, NE * 2 * I_G + l * CONV_S};
              tr_loop<true>(mk, CONV_S, (bx - (G - nidle)) * NWAVES + wave_, nidle * NWAVES, scr, lane_);
              __syncthreads(); } }
    } else if (op_ == OP_OUTPROJ) {
        unsigned* rt = A.ctl + 28672 + l * 1024; unsigned* tmo = A.ctl + 4096 + XB_TMO;
        { pg8::DenseOrder S; S.init(A.mixb, A.wout_t + (size_t)l * DM * DM, T, DM, DM, G, bx);
          EpiResid E{A.hb, rt};
          pg8::gemm_phase<EpiResid, pg8::DenseOrder, false>(lds, S, E); }
        for (int tile = bx; tile < T / 32; tile += G) {
            __syncthreads();
            if (tidx() == 0) { unsigned sp = 0;
                while (xb_ld(rt + 16 * (tile >> 3)) < 64u) { __builtin_amdgcn_s_sleep(1); if ((++sp & 255u) == 0u) { if (xb_ld(tmo)) break; if (sp > XB_SPIN_CAP) { atomicAdd(tmo, 1u); break; } } }
                __builtin_amdgcn_fence(__ATOMIC_ACQUIRE, "agent");
                asm volatile("s_waitcnt vmcnt(0)" ::: "memory"); }
            __syncthreads();
            stats_route_tile(A, l, tile, (char*)lds_raw, tidx());
        }
    } else if (op_ == OP_MIX) {
        const int WG = G >= 116 ? 58 : G / 2, NA = G - WG;
        unsigned* sbc = A.ctl + 12288 + l * 64; unsigned* tmo = A.ctl + 4096 + XB_TMO;
        unsigned* p1c = A.ctl + 20480 + l * 64; unsigned* hq1 = A.ctl + 24576 + l * 64;
        volatile LAS int* nu = (volatile LAS int*)(lds + MISC_OFF + 4096);
        if (bx >= NA) { const int wb = bx - NA;
            S5Order S; S.A = A.ug; S.Bt = A.s5et + (size_t)l * SG * 256 * 512; S.K = 512; S.lda = S5LD; S.gstrideB = (size_t)256 * 512; S.NP = 1; S.G = WG; S.c = wb;
            EpiS5A E{A.xend};
            pg8::gemm_phase<EpiS5A, S5Order, false>(lds, S, E); }
        { unsigned pf = 0u;
          __syncthreads();
          if (tidx() == 0) nu[0] = (int)atomicAdd(hq1, 1u);
          __syncthreads();
          int u = nu[0];
          for (int k = 0; u < hg::NUN; ++k)
              u = hg::hg1_unit(A, u, (char*)lds_raw, tidx(), bx >= NA || k + 1 < 3, hq1, nu, pf);
          asm volatile("s_waitcnt vmcnt(0)" ::: "memory"); asm volatile("" :: "v"(pf)); }
        asm volatile("s_waitcnt vmcnt(0)" ::: "memory");
        __syncthreads();
        if (tidx() == 0) { __builtin_amdgcn_fence(__ATOMIC_RELEASE, "agent"); asm volatile("s_waitcnt vmcnt(0)" ::: "memory"); xb_add(p1c, 1u); }
        if (bx < NA) {
            att::phase_static((char*)lds_raw, A.qb, A.kb, A.vb, A.mixb, A.in[5], A.in[6] + l * 4 * DK, A.in[7] + l * DV, l, bx, NA);
            __syncthreads();
            if (tidx() == 0) { unsigned sp = 0;
                while (xb_ld(sbc) < (unsigned)WG) { __builtin_amdgcn_s_sleep(1); if ((++sp & 255u) == 0u) { if (xb_ld(tmo)) break; if (sp > XB_SPIN_CAP) { atomicAdd(tmo, 1u); break; } } }
                __builtin_amdgcn_fence(__ATOMIC_ACQUIRE, "agent");
                asm volatile("s_waitcnt vmcnt(0)" ::: "memory"); }
            __syncthreads();
        } else {
            const int wb = bx - NA;
            if (tidx() == 0) { unsigned sp = 0;
                while (xb_ld(p1c) < (unsigned)G) { __builtin_amdgcn_s_sleep(1); if ((++sp & 255u) == 0u) { if (xb_ld(tmo)) break; if (sp > XB_SPIN_CAP) { atomicAdd(tmo, 1u); break; } } }
                __builtin_amdgcn_fence(__ATOMIC_ACQUIRE, "agent");
                asm volatile("s_waitcnt vmcnt(0)" ::: "memory"); }
            __syncthreads();
            { constexpr int NIT = BATCH * HH * HD * (HD / 4); const int per = (NIT + WG - 1) / WG, lo = wb * per, cw = lo < NIT ? (NIT - lo < per ? NIT - lo : per) : 0;
              bool first = true;
              for (int it = wb; it < BATCH * SG; it += WG) {
                  if (first) { hg::Hg2Side side{&A, lo, cw}; s5_scan_unit(A, l, it / SG, it % SG, (LAS float*)lds, tidx(), side); first = false; }
                  else s5_scan_unit(A, l, it / SG, it % SG, (LAS float*)lds, tidx()); }
              if (first) hg::hg2_share(A, lo, cw, tidx(), NTHR); }
            sub_barrier(sbc, (unsigned)WG, 0u, tmo);
            { S5Order S; S.A = A.ug; S.Bt = A.s5mf + (size_t)l * SG * 512 * 640; S.K = 640; S.lda = S5LD; S.gstrideB = (size_t)512 * 640; S.NP = 2; S.G = WG; S.c = wb;
              EpiS5C E{A.zb};
              pg8::gemm_phase<EpiS5C, S5Order, false>(lds, S, E); }
            sub_barrier(sbc, (unsigned)WG, 1u, tmo);
            { pg8::DenseOrder S; S.init(A.zb, A.wglu_t + (size_t)l * 768 * SW, T, 768, SW, WG, wb);
              EpiGLU E{A.zb, A.mixb};
              pg8::gemm_phase<EpiGLU, pg8::DenseOrder, false>(lds, S, E); }
        }
        { unsigned* hq3 = A.ctl + 16384 + l * 64;
          unsigned pf0 = 0u, pf1 = 0u;
          __syncthreads();
          if (tidx() == 0) nu[0] = (int)atomicAdd(hq3, 1u);
          __syncthreads();
          int u = nu[0];
          while (u < hg::NUN) u = hg::hg3_unit(A, l, u, (char*)lds_raw, tidx(), hq3, nu, pf0, pf1);
          asm volatile("s_waitcnt vmcnt(0)" ::: "memory"); asm volatile("" :: "v"(pf0), "v"(pf1)); }
    } else if (op_ == OP_MOEGU) {
        PH_IDS;
        LAS int* tpre = (LAS int*)(lds + MISC_OFF); LAS int* rowsl = (LAS int*)(lds + MISC_OFF + 1024);
        const int* cnt = (const int*)(A.ctl + 65536 + l * 4096);
        unsigned* ready = A.ctl + 32768 + l * 2048; unsigned* tmo = A.ctl + 4096 + XB_TMO;
        moe_tiles(cnt, tpre, tid);
        const int nGU = tpre[NE] * 4, H = nGU > G ? (nGU - G < G ? nGU - G : G) : 0;
        { MoeOrder S; S.A = A.hb; S.Bt = A.wgu_t + (size_t)l * NE * 1024 * DM; S.K = DM; S.lda = DM; S.estride = (size_t)1024 * DM; S.NP = 4; S.G = G; S.c = moe_rank(bx, 0, G); S.gather = true; S.tpre = tpre; S.rowsl = rowsl;
          S.ready = nullptr; S.need = 0; S.tmo = tmo;
          { pg8::Unit u; for (int i = 0; S.next(i, u); ++i) { const int ce = tpre[64 + u.e], p0 = (u.pm - tpre[u.e]) * 256;
              for (int r = tid; r < 256; r += NTHR) { const int pos = p0 + r; rowsl[i * 256 + r] = A.tokl[(size_t)u.e * T + (pos < ce ? pos : 0)]; } } }
          __syncthreads();
          EpiGU E{A.rstd, A.hmid, rowsl, ready};
          pg8::gemm_phase<EpiGU, MoeOrder, true>(lds, S, E); }
        { MoeOrder S; S.A = A.hmid; S.Bt = A.wd_t + (size_t)l * NE * DM * DE; S.K = DE; S.lda = DE; S.estride = (size_t)DM * DE; S.NP = 8; S.gather = false; S.tpre = tpre; S.rowsl = nullptr;
          { const int r = moe_rank(bx, 0, G);
            if (H > 0 && H < G) { S.G = G - H; S.c = r >= H ? r - H : -1; } else { S.G = G; S.c = r; } }
          S.ready = ready; S.need = 32u; S.tmo = tmo;
          EpiDown E{A.gl, cnt, A.ybuf, tpre};
          pg8::gemm_phase<EpiDown, MoeOrder, false>(lds, S, E); }
    } else if (op_ == OP_COMBINE) {
        PH_IDS;
        LAS int* tpre = (LAS int*)(lds + MISC_OFF);
#ifdef MK_PER_PHASE
        { const int* cnt = (const int*)(A.ctl + 65536 + l * 4096); moe_tiles(cnt, tpre, tid); }
#endif
        const bool lastl = (l == DEPTH - 1);
        const float* gfin = A.in[24];
        unsigned* rtc = A.ctl + 49152 + l * 1024;
        for (int tile = bx; tile < T / 32; tile += G) {
          const int m0 = tile * 32 + wave * 4;
          int s0a[4], s1a[4];
#pragma unroll
          for (int k4 = 0; k4 < 4; ++k4) { s0a[k4] = A.sl[(m0 + k4) * 2]; s1a[k4] = A.sl[(m0 + k4) * 2 + 1]; }
          v2u X[2][8], P[2][8], Q[2][8];
#define CMB_LOAD(k4, bf) do { const int s0 = s0a[k4], s1 = s1a[k4];                                                                    \
            const size_t r0 = (size_t)tpre[s0 >> 16] * 256 + (s0 & 0xffff), r1 = (size_t)tpre[s1 >> 16] * 256 + (s1 & 0xffff);         \
            const GAS v2u* xr = (const GAS v2u*)(A.hb + (size_t)(m0 + (k4)) * DM) + lane;                                              \
            const GAS v2u* y0 = (const GAS v2u*)(A.ybuf + r0 * DM) + lane; const GAS v2u* y1 = (const GAS v2u*)(A.ybuf + r1 * DM) + lane; \
            _Pragma("unroll") for (int j = 0; j < 8; ++j) { X[bf][j] = xr[64 * j]; P[bf][j] = y0[64 * j]; Q[bf][j] = y1[64 * j]; } } while (0)
          CMB_LOAD(0, 0);
#pragma unroll
          for (int k4 = 0; k4 < 4; ++k4) { const int m = m0 + k4; const int bf = k4 & 1;
            if (k4 == 0) CMB_LOAD(1, 1); else if (k4 == 1) CMB_LOAD(2, 0); else if (k4 == 2) CMB_LOAD(3, 1);
            f32x4 v[8]; float ss = 0.f;
#pragma unroll
            for (int j = 0; j < 8; ++j) { const v2u x = X[bf][j], p = P[bf][j], q = Q[bf][j];
                v[j].x = __builtin_bit_cast(float, x.x << 16) + __builtin_bit_cast(float, p.x << 16) + __builtin_bit_cast(float, q.x << 16);
                v[j].y = __builtin_bit_cast(float, x.x & 0xffff0000u) + __builtin_bit_cast(float, p.x & 0xffff0000u) + __builtin_bit_cast(float, q.x & 0xffff0000u);
                v[j].z = __builtin_bit_cast(float, x.y << 16) + __builtin_bit_cast(float, p.y << 16) + __builtin_bit_cast(float, q.y << 16);
                v[j].w = __builtin_bit_cast(float, x.y & 0xffff0000u) + __builtin_bit_cast(float, p.y & 0xffff0000u) + __builtin_bit_cast(float, q.y & 0xffff0000u);
                if (!lastl) { v2u w; w.x = pk2(v[j].x, v[j].y); w.y = pk2(v[j].z, v[j].w);
                    v[j].x = __builtin_bit_cast(float, w.x << 16); v[j].y = __builtin_bit_cast(float, w.x & 0xffff0000u); v[j].z = __builtin_bit_cast(float, w.y << 16); v[j].w = __builtin_bit_cast(float, w.y & 0xffff0000u); }
                ss += (v[j].x * v[j].x + v[j].y * v[j].y) + (v[j].z * v[j].z + v[j].w * v[j].w); }
            ss = wave_sum(ss);
            const float rs = 1.0f / sqrtf(ss * (1.f / DM) + EPS);
            if (lastl) {
                GAS f32x4* o = (GAS f32x4*)(A.out + (size_t)m * DM) + lane;
#pragma unroll
                for (int j = 0; j < 8; ++j) { const f32x4 g = *((const GAS f32x4*)gfin + lane + 64 * j); o[64 * j] = v[j] * rs * g; }
            } else {
                if (lane == 0) __hip_atomic_store(A.rstd + m, rs, __ATOMIC_RELAXED, __HIP_MEMORY_SCOPE_AGENT);
                bf16* o8 = A.hb + (size_t)m * DM + lane * 4;
#pragma unroll
                for (int j = 0; j < 8; ++j) { v2u w; w.x = pk2(v[j].x, v[j].y); w.y = pk2(v[j].z, v[j].w); bf16* dp = o8 + 256 * j;
                    asm volatile("global_store_dwordx2 %0, %1, off sc1\n\ts_nop 1" :: "v"(dp), "v"(w) : "memory"); }
            }
          }
#undef CMB_LOAD
          if (!lastl) {
              asm volatile("s_waitcnt vmcnt(0)" ::: "memory");
              if (lane == 0) __hip_atomic_fetch_add(rtc + 16 * (tile >> 3), 1u, __ATOMIC_RELAXED, __HIP_MEMORY_SCOPE_AGENT);
          }
        }
    }
  }
}

extern "C" void kernel_launch(void* const* d_in, const int* in_sizes, int n_in, void* d_out, int out_size, void* d_ws, size_t ws_size, hipStream_t stream) {
    static int grid = 0;
    if (grid == 0) {
        int dev = 0, cus = 0;
        if (hipGetDevice(&dev) != hipSuccess || hipDeviceGetAttribute(&cus, hipDeviceAttributeMultiprocessorCount, dev) != hipSuccess) { fprintf(stderr, "kernel_launch: device query failed\n"); grid = -1; return; }
        if (hipFuncSetAttribute((const void*)mega, hipFuncAttributeMaxDynamicSharedMemorySize, LDS_BYTES) != hipSuccess) { fprintf(stderr, "kernel_launch: hipFuncSetAttribute failed\n"); grid = -1; return; }
        grid = cus;
    }
    if (grid < 0) return;
    const float* const* in = (const float* const*)d_in;
    float* out = (float*)d_out;

    if (O_END > ws_size) { fprintf(stderr, "kernel_launch: workspace too small: need %zu have %zu\n", (size_t)O_END, ws_size); return; }
    KArgs a{};
    for (int i = 0; i < 25; ++i) a.in[i] = in[i];
    a.out = out; a.ws = (unsigned char*)d_ws;
    if (hipMemsetAsync((unsigned char*)d_ws + O_CTL, 0, 1 << 20, stream) != hipSuccess) { fprintf(stderr, "kernel_launch: memset failed\n"); return; }
#ifdef MK_PER_PHASE
    for (int i = 0; i < NPROG; ++i) { KArgs b = a; b.pi0 = i; b.nprog = 1; hipLaunchKernelGGL(mega, dim3(grid), dim3(NTHR), LDS_BYTES, stream, b); }
#else
    a.pi0 = 0; a.nprog = NPROG;
    hipLaunchKernelGGL(mega, dim3(grid), dim3(NTHR), LDS_BYTES, stream, a);
#endif
}
```
